# Optimizing an MI355X kernel written in HIP

```python
import jax, jax.numpy as jnp
from jax import lax
import numpy as np

D_MODEL = 1024
BATCH = 2
SEQ = 8192
DEPTH = 1

CHUNK = 64
N_MEM = 256
HGRN_HEADS = 4
HGRN_DK = 128
HGRN_DV = 128
HGRN_QK = HGRN_HEADS * HGRN_DK
HGRN_WIDTH = HGRN_HEADS * HGRN_DV
SB_HEADS = 8
SB_HEAD_DIM = 64
SB_WIDTH = SB_HEADS * SB_HEAD_DIM
SB_BLOCK = 128
XATTN_HEADS = 4
XATTN_HEAD_DIM = D_MODEL // XATTN_HEADS
D_FF = ((8 * D_MODEL // 3 + 255) // 256) * 256
EPS = 1e-6
IN_SIZES = (HGRN_QK, HGRN_QK, HGRN_WIDTH, HGRN_WIDTH, SB_WIDTH, SB_WIDTH, SB_WIDTH)
IN_OFFSETS = tuple(int(v) for v in np.cumsum(IN_SIZES)[:-1])
D_IN = int(sum(IN_SIZES))

kernel_name = 'hybrid_hgrn2_stickbreaking_xattn_block'


def rms_norm(x, gain):
    xf = x.astype(jnp.float32)
    y = xf * lax.rsqrt(jnp.mean(xf * xf, axis=-1, keepdims=True) + EPS)
    return (y * gain.astype(jnp.float32)).astype(x.dtype)


def hgrn2_mixer(q, f_pre, i, g, lb, norm_gain):
    B, T, _ = q.shape
    nc = T // CHUNK
    f32 = jnp.float32
    lbf = lb.astype(f32)
    q = jax.nn.silu(q.astype(f32))
    f = lbf + (1.0 - lbf) * jax.nn.sigmoid(f_pre.astype(f32))
    k = 1.0 - f
    log_f = jnp.log(f)

    def to_chunks(t, d):
        return t.reshape(B, nc, CHUNK, HGRN_HEADS, d).transpose(1, 0, 3, 2, 4)

    qc = to_chunks(q, HGRN_DK)
    kc = to_chunks(k, HGRN_DK)
    lfc = to_chunks(log_f, HGRN_DK)
    vc = to_chunks(i.astype(f32), HGRN_DV)
    tri = jnp.tril(jnp.ones((CHUNK, CHUNK), dtype=bool))[:, :, None]

    def step(S, xs):
        q_c, k_c, lf_c, v_c = xs
        b = jnp.cumsum(lf_c, axis=-2)
        diff = b[:, :, :, None, :] - b[:, :, None, :, :]
        decay = jnp.where(tri, jnp.exp(jnp.where(tri, diff, 0.0)), 0.0)
        scores = jnp.einsum('bhtd,bhsd,bhtsd->bhts', q_c, k_c, decay)
        o = (jnp.einsum('bhts,bhsv->bhtv', scores, v_c)
             + jnp.einsum('bhtd,bhdv->bhtv', q_c * jnp.exp(b), S))
        b_last = b[:, :, -1:, :]
        S = (jnp.exp(b_last[:, :, 0, :])[..., None] * S
             + jnp.einsum('bhsd,bhsv->bhdv', k_c * jnp.exp(b_last - b), v_c))
        return S, o

    S0 = jnp.zeros((B, HGRN_HEADS, HGRN_DK, HGRN_DV), f32)
    _, o = lax.scan(step, S0, (qc, kc, lfc, vc))
    o = o.transpose(1, 0, 3, 2, 4).reshape(B, T, HGRN_HEADS, HGRN_DV)
    o = rms_norm(o, norm_gain.reshape(HGRN_HEADS, HGRN_DV)).reshape(B, T, HGRN_WIDTH)
    return (o * jax.nn.silu(g.astype(f32))).astype(g.dtype)


def stick_breaking_mixer(q, k, v):
    B, T, _ = q.shape
    f32 = jnp.float32
    nq = T // SB_BLOCK
    scale = SB_HEAD_DIM ** -0.5
    qh = q.astype(f32).reshape(B, T, SB_HEADS, SB_HEAD_DIM).transpose(0, 2, 1, 3)
    kh = k.astype(f32).reshape(B, T, SB_HEADS, SB_HEAD_DIM).transpose(0, 2, 1, 3)
    vh = v.astype(f32).reshape(B, T, SB_HEADS, SB_HEAD_DIM).transpose(0, 2, 1, 3)
    qb = qh.reshape(B, SB_HEADS, nq, SB_BLOCK, SB_HEAD_DIM).transpose(2, 0, 1, 3, 4)
    key_pos = jnp.arange(T)

    def block(args):
        q_blk, blk = args
        z = jnp.einsum('bhqd,bhkd->bhqk', q_blk, kh) * scale
        q_pos = blk * SB_BLOCK + jnp.arange(SB_BLOCK)
        causal = key_pos[None, :] < q_pos[:, None]
        log_rest = jnp.where(causal, jax.nn.log_sigmoid(-z), 0.0)
        between = lax.cumsum(log_rest, axis=3, reverse=True) - log_rest
        log_a = jax.nn.log_sigmoid(z) + between
        a = jnp.where(causal, jnp.exp(log_a), 0.0)
        return jnp.einsum('bhqk,bhkd->bhqd', a, vh)

    o = lax.map(block, (qb, jnp.arange(nq)))
    o = o.transpose(1, 0, 3, 2, 4).reshape(B, T, SB_WIDTH)
    return o.astype(q.dtype)


def cross_attention(h, m, w_q, w_kv, w_o):
    B, T, _ = h.shape
    f32 = jnp.float32
    q = (h @ w_q).reshape(B, T, XATTN_HEADS, XATTN_HEAD_DIM)
    k, v = jnp.split(m @ w_kv, 2, axis=-1)
    k = k.reshape(B, N_MEM, XATTN_HEADS, XATTN_HEAD_DIM)
    v = v.reshape(B, N_MEM, XATTN_HEADS, XATTN_HEAD_DIM)
    s = jnp.einsum('bthd,bnhd->bhtn', q.astype(f32), k.astype(f32)) * (XATTN_HEAD_DIM ** -0.5)
    p = jax.nn.softmax(s, axis=-1)
    o = jnp.einsum('bhtn,bnhd->bthd', p, v.astype(f32)).reshape(B, T, D_MODEL)
    return o.astype(h.dtype) @ w_o


def swiglu(h, w_in, w_out):
    gate, up = jnp.split(h @ w_in, 2, axis=-1)
    return (jax.nn.silu(gate) * up) @ w_out


def setup_inputs(seed: int = 0) -> dict:
    key = jax.random.key(seed)
    ks = jax.random.split(key, 20)

    def w(k, shape, fan_in):
        return jax.random.normal(k, shape, jnp.float32) * fan_in ** -0.5

    def gain(k, shape):
        return 1.0 + 0.02 * jax.random.normal(k, shape, jnp.float32)

    return dict(
        x=jax.random.normal(ks[0], (BATCH, SEQ, D_MODEL), jnp.float32),
        mem=jax.random.normal(ks[1], (BATCH, N_MEM, D_MODEL), jnp.float32),
        g_mix=gain(ks[2], (DEPTH, D_MODEL)),
        w_in=w(ks[3], (DEPTH, D_MODEL, D_IN), D_MODEL),
        lb_table=0.5 * jax.random.normal(ks[4], (DEPTH + 1, HGRN_QK), jnp.float32),
        g_hgrn=gain(ks[5], (DEPTH, HGRN_WIDTH)),
        w_gate=w(ks[6], (DEPTH, D_MODEL, 2 * D_MODEL), D_MODEL),
        w_proj_a=w(ks[7], (DEPTH, HGRN_WIDTH, D_MODEL), HGRN_WIDTH),
        w_proj_b=w(ks[8], (DEPTH, SB_WIDTH, D_MODEL), SB_WIDTH),
        w_out=w(ks[9], (DEPTH, D_MODEL, D_MODEL), D_MODEL),
        g_xattn=gain(ks[10], (DEPTH, D_MODEL)),
        g_mem=gain(ks[11], (DEPTH, D_MODEL)),
        w_xq=w(ks[12], (DEPTH, D_MODEL, D_MODEL), D_MODEL),
        w_xkv=w(ks[13], (DEPTH, D_MODEL, 2 * D_MODEL), D_MODEL),
        w_xo=w(ks[14], (DEPTH, D_MODEL, D_MODEL), D_MODEL),
        g_ffn=gain(ks[15], (DEPTH, D_MODEL)),
        w_ffn_in=w(ks[16], (DEPTH, D_MODEL, 2 * D_FF), D_MODEL),
        w_ffn_out=w(ks[17], (DEPTH, D_FF, D_MODEL), D_FF),
        g_final=gain(ks[18], (D_MODEL,)),
    )


def reference(x, mem, g_mix, w_in, lb_table, g_hgrn, w_gate, w_proj_a, w_proj_b, w_out,
              g_xattn, g_mem, w_xq, w_xkv, w_xo, g_ffn, w_ffn_in, w_ffn_out, g_final):
    lb_all = jnp.cumsum(jax.nn.softmax(lb_table.astype(jnp.float32), axis=0), axis=0)
    for l in range(DEPTH):
        h = rms_norm(x, g_mix[l])
        q_a, f_a, i_a, o_a, q_b, k_b, v_b = jnp.split(h @ w_in[l], IN_OFFSETS, axis=-1)
        y_a = hgrn2_mixer(q_a, f_a, i_a, o_a, lb_all[l], g_hgrn[l])
        y_b = stick_breaking_mixer(q_b, k_b, v_b)
        gate_a, gate_b = jnp.split(jax.nn.sigmoid(h @ w_gate[l]), 2, axis=-1)
        merged = gate_a * (y_a @ w_proj_a[l]) + gate_b * (y_b @ w_proj_b[l])
        x = x + merged @ w_out[l]
        x = x + cross_attention(rms_norm(x, g_xattn[l]), rms_norm(mem, g_mem[l]),
                                w_xq[l], w_xkv[l], w_xo[l])
        x = x + swiglu(rms_norm(x, g_ffn[l]), w_ffn_in[l], w_ffn_out[l])
    return rms_norm(x, g_final)
```

```cpp
#include <hip/hip_runtime.h>
#include <hip/hip_cooperative_groups.h>
#include <cstdio>
#include <cstdint>
namespace cg = cooperative_groups;
namespace pg8 {
#define PG8_LAS __attribute__((address_space(3)))
typedef unsigned short bf16_t;
typedef short bf16x8 __attribute__((ext_vector_type(8)));
typedef float f32x4 __attribute__((ext_vector_type(4)));
typedef unsigned u32x4 __attribute__((ext_vector_type(4)));
constexpr int BM = 256, BK = 64, HALF = 128, HTB = HALF * BK * 2  , STAGE_BYTES = 8 * HTB, NXCD = 8, WGM = 8;

__host__ __device__ __forceinline__ int lds_byte(int r, int c) { const int st = (r >> 4) * 2 + (c >> 5), rr = r & 15, cc = c & 31, ob = rr * 64 + cc * 2; return st * 1024 + (ob ^ (((ob >> 9) & 1) << 5)); }
__host__ __device__ __forceinline__ void stage_rc(int b, int& R, int& C) { const int st = b / 1024, sb = b % 1024, swz = sb ^ (((sb >> 9) & 1) << 5); R = (st >> 1) * 16 + swz / 64; C = (st & 1) * 32 + (swz % 64) / 2; }
__host__ __device__ __forceinline__ int perm32(int rho) { const int n = rho >> 4, i = rho & 15; return 8 * (i >> 2) + 4 * n + (i & 3); }

struct Unit { int pm, pn; };
struct Gemm { const bf16_t* A; const bf16_t* Bt; int M, N, K; };

struct StaticOrder {
    int nM, nN, nwg, G, c;
    __host__ __device__ void init(int M, int N, int G_, int c_) { nM = M / BM; nN = N / BM; nwg = nM * nN; G = G_; c = c_; }
    __host__ __device__ bool next(int i, Unit& u) const {
        const long L = (long)i * G + c; if (L >= nwg) return false;
        int wgid = (int)L; { const int q = nwg / NXCD, r = nwg % NXCD, xcd = wgid % NXCD, off = wgid / NXCD; wgid = (xcd < r ? xcd * (q + 1) : r * (q + 1) + (xcd - r) * q) + off; }
        const int nig = WGM * nN, gid = wgid / nig, fm = gid * WGM, gsz = (nM - fm) < WGM ? (nM - fm) : WGM;
        u.pm = fm + ((wgid % nig) % gsz); u.pn = (wgid % nig) / gsz; return true;
    }
    __device__ __forceinline__ void a_ready(const Unit&) const {}
    __device__ __forceinline__ void done(const Unit&) const {}
};
typedef unsigned u32x2 __attribute__((ext_vector_type(2)));

__device__ __forceinline__ unsigned cvt_pk_bf16(float lo, float hi) { unsigned r; asm volatile("v_cvt_pk_bf16_f32 %0, %1, %2" : "=v"(r) : "v"(lo), "v"(hi)); return r; }
__device__ __forceinline__ float bf2f(unsigned short b) { return __uint_as_float((unsigned)b << 16); }
__device__ __forceinline__ float bflo(unsigned w) { return __uint_as_float(w << 16); }
__device__ __forceinline__ float bfhi(unsigned w) { return __uint_as_float(w & 0xffff0000u); }
__device__ __forceinline__ float fsigmoid(float x) { return __builtin_amdgcn_rcpf(1.f + __expf(-x)); }
__device__ __forceinline__ float fsilu(float x) { return x * fsigmoid(x); }
constexpr float RMS_EPS = 1e-6f;

struct EpiMain {
    static constexpr bool PERM = true, AFTER_DRAIN = false;
    bf16_t *QA, *GA, *QB, *KB, *GATE; float* LF; const float* lbt;
    __device__ __forceinline__ void operator()(const f32x4 (&acc)[2][2][4][2], const Unit& u, int wr, int wc, int fr, int fq) const {
        const int pn = u.pn; const int row0 = u.pm * BM + wr * 64 + fr; const int cin = wc * 32 + 8 * fq;
        if (pn == 2 || pn == 3) {
#pragma unroll
            for (int bj = 0; bj < 2; ++bj) {
                const int col = (pn - 2) * 256 + bj * HALF + cin;
                float lb[8];
#pragma unroll
                for (int e = 0; e < 8; ++e) { const float t0 = lbt[col + e], t1 = lbt[512 + col + e]; lb[e] = 1.f / (1.f + __expf(t1 - t0)); }
#pragma unroll
                for (int ai = 0; ai < 2; ++ai)
#pragma unroll
                    for (int m = 0; m < 4; ++m) {
                        float* p = LF + (size_t)(row0 + ai * HALF + m * 16) * 512 + col;
                        const f32x4 v0 = acc[ai][bj][m][0], v1 = acc[ai][bj][m][1]; f32x4 o0, o1;
#pragma unroll
                        for (int e = 0; e < 4; ++e) { o0[e] = __logf(lb[e] + (1.f - lb[e]) * fsigmoid(v0[e])); o1[e] = __logf(lb[4 + e] + (1.f - lb[4 + e]) * fsigmoid(v1[e])); }
                        *(f32x4*)p = o0; *(f32x4*)(p + 4) = o1;
                    }
            }
            return;
        }
        int mode; bf16_t* O; int ldc, colt;
        if (pn < 2) { mode = 1; O = QA; ldc = 512; colt = pn * 256; }
        else if (pn < 6) { mode = 1; O = GA; ldc = 512; colt = (pn - 4) * 256; }
        else if (pn < 8) { mode = 2; O = QB; ldc = 512; colt = (pn - 6) * 256; }
        else if (pn < 10) { mode = 0; O = KB; ldc = 512; colt = (pn - 8) * 256; }
        else { mode = 3; O = GATE; ldc = 2048; colt = (pn - 10) * 256; }
#pragma unroll
        for (int ai = 0; ai < 2; ++ai)
#pragma unroll
            for (int m = 0; m < 4; ++m) { bf16_t* rowp = O + (size_t)(row0 + ai * HALF + m * 16) * ldc + colt + cin;
#pragma unroll
                for (int bj = 0; bj < 2; ++bj) { f32x4 v0 = acc[ai][bj][m][0], v1 = acc[ai][bj][m][1];
                    if (mode == 1) {
#pragma unroll
                        for (int e = 0; e < 4; ++e) { v0[e] = fsilu(v0[e]); v1[e] = fsilu(v1[e]); } }
                    else if (mode == 2) { v0 = v0 * 0.125f; v1 = v1 * 0.125f; }
                    else if (mode == 3) {
#pragma unroll
                        for (int e = 0; e < 4; ++e) { v0[e] = fsigmoid(v0[e]); v1[e] = fsigmoid(v1[e]); } }
                    u32x4 w; w.x = cvt_pk_bf16(v0[0], v0[1]); w.y = cvt_pk_bf16(v0[2], v0[3]); w.z = cvt_pk_bf16(v1[0], v1[1]); w.w = cvt_pk_bf16(v1[2], v1[3]);
                    *(u32x4*)(rowp + bj * HALF) = w; } }
    }
};
struct EpiStore {
    static constexpr bool PERM = true, AFTER_DRAIN = false;
    bf16_t* O; int ldc;
    __device__ __forceinline__ void operator()(const f32x4 (&acc)[2][2][4][2], const Unit& u, int wr, int wc, int fr, int fq) const {
        const int row0 = u.pm * BM + wr * 64 + fr; const int col0 = u.pn * BM + wc * 32 + 8 * fq;
#pragma unroll
        for (int ai = 0; ai < 2; ++ai)
#pragma unroll
            for (int m = 0; m < 4; ++m) { bf16_t* rowp = O + (size_t)(row0 + ai * HALF + m * 16) * ldc + col0;
#pragma unroll
                for (int bj = 0; bj < 2; ++bj) { const f32x4 v0 = acc[ai][bj][m][0], v1 = acc[ai][bj][m][1];
                    u32x4 w; w.x = cvt_pk_bf16(v0[0], v0[1]); w.y = cvt_pk_bf16(v0[2], v0[3]); w.z = cvt_pk_bf16(v1[0], v1[1]); w.w = cvt_pk_bf16(v1[2], v1[3]);
                    *(u32x4*)(rowp + bj * HALF) = w; } }
    }
};
struct EpiGate {
    static constexpr bool PERM = true, AFTER_DRAIN = false;
    const bf16_t* gate; const bf16_t* addin; bf16_t* out;
    __device__ __forceinline__ void operator()(const f32x4 (&acc)[2][2][4][2], const Unit& u, int wr, int wc, int fr, int fq) const {
        const int row0 = u.pm * BM + wr * 64 + fr; const int col0 = u.pn * BM + wc * 32 + 8 * fq;
#pragma unroll
        for (int ai = 0; ai < 2; ++ai)
#pragma unroll
            for (int m = 0; m < 4; ++m) { const size_t row = (size_t)(row0 + ai * HALF + m * 16);
#pragma unroll
                for (int bj = 0; bj < 2; ++bj) { const f32x4 v0 = acc[ai][bj][m][0], v1 = acc[ai][bj][m][1]; const int col = col0 + bj * HALF;
                    const u32x4 g = *(const u32x4*)(gate + row * 2048 + col);
                    float r[8] = { bflo(g.x) * v0[0], bfhi(g.x) * v0[1], bflo(g.y) * v0[2], bfhi(g.y) * v0[3], bflo(g.z) * v1[0], bfhi(g.z) * v1[1], bflo(g.w) * v1[2], bfhi(g.w) * v1[3] };
                    if (addin) { const u32x4 t = *(const u32x4*)(addin + row * 1024 + col);
                        r[0] += bflo(t.x); r[1] += bfhi(t.x); r[2] += bflo(t.y); r[3] += bfhi(t.y); r[4] += bflo(t.z); r[5] += bfhi(t.z); r[6] += bflo(t.w); r[7] += bfhi(t.w); }
                    u32x4 w; w.x = cvt_pk_bf16(r[0], r[1]); w.y = cvt_pk_bf16(r[2], r[3]); w.z = cvt_pk_bf16(r[4], r[5]); w.w = cvt_pk_bf16(r[6], r[7]);
                    *(u32x4*)(out + row * 1024 + col) = w; } }
    }
};
struct EpiResid {
    static constexpr bool PERM = false, AFTER_DRAIN = false;
    const float* base; float* out; bf16_t* xb; float* rowss;
    __device__ __forceinline__ void operator()(const f32x4 (&acc)[2][2][4][2], const Unit& u, int wr, int wc, int fr, int fq) const {
        const int row0 = u.pm * BM + wr * 64 + fr; const int col0 = u.pn * BM + wc * 32 + 4 * fq;
#pragma unroll
        for (int ai = 0; ai < 2; ++ai)
#pragma unroll
            for (int m = 0; m < 4; ++m) { const size_t row = (size_t)(row0 + ai * HALF + m * 16); float ss = 0.f;
#pragma unroll
                for (int bj = 0; bj < 2; ++bj)
#pragma unroll
                    for (int n = 0; n < 2; ++n) { const size_t off = row * 1024 + col0 + bj * HALF + n * 16;
                        const f32x4 v = *(const f32x4*)(base + off) + acc[ai][bj][m][n];
                        *(f32x4*)(out + off) = v; ss += (v[0] * v[0] + v[1] * v[1]) + (v[2] * v[2] + v[3] * v[3]);
                        if (xb) { u32x2 w; w.x = cvt_pk_bf16(v[0], v[1]); w.y = cvt_pk_bf16(v[2], v[3]); *(u32x2*)(xb + off) = w; } }
                ss += __shfl_xor(ss, 16); ss += __shfl_xor(ss, 32);
                if (fq == 0) unsafeAtomicAdd(rowss + row, ss); }
    }
};
struct EpiRowScale {
    static constexpr bool PERM = true, AFTER_DRAIN = false;
    const float* rowss; bf16_t* out; float scale;
    __device__ __forceinline__ void operator()(const f32x4 (&acc)[2][2][4][2], const Unit& u, int wr, int wc, int fr, int fq) const {
        const int row0 = u.pm * BM + wr * 64 + fr; const int col0 = u.pn * BM + wc * 32 + 8 * fq;
#pragma unroll
        for (int ai = 0; ai < 2; ++ai)
#pragma unroll
            for (int m = 0; m < 4; ++m) { const size_t row = (size_t)(row0 + ai * HALF + m * 16); const float rs = rsqrtf(rowss[row] * (1.f / 1024.f) + RMS_EPS) * scale;
#pragma unroll
                for (int bj = 0; bj < 2; ++bj) { const f32x4 v0 = acc[ai][bj][m][0] * rs, v1 = acc[ai][bj][m][1] * rs;
                    u32x4 w; w.x = cvt_pk_bf16(v0[0], v0[1]); w.y = cvt_pk_bf16(v0[2], v0[3]); w.z = cvt_pk_bf16(v1[0], v1[1]); w.w = cvt_pk_bf16(v1[2], v1[3]);
                    *(u32x4*)(out + row * 1024 + col0 + bj * HALF) = w; } }
    }
};
struct EpiSwiglu {
    static constexpr bool PERM = true, AFTER_DRAIN = false;
    const float* rowss; bf16_t* out;
    __device__ __forceinline__ void operator()(const f32x4 (&acc)[2][2][4][2], const Unit& u, int wr, int wc, int fr, int fq) const {
        const int row0 = u.pm * BM + wr * 64 + fr; const int col0 = u.pn * HALF + wc * 32 + 8 * fq;
#pragma unroll
        for (int ai = 0; ai < 2; ++ai)
#pragma unroll
            for (int m = 0; m < 4; ++m) { const size_t row = (size_t)(row0 + ai * HALF + m * 16); const float rs = rsqrtf(rowss[row] * (1.f / 1024.f) + RMS_EPS);
                float r[8];
#pragma unroll
                for (int n = 0; n < 2; ++n)
#pragma unroll
                    for (int e = 0; e < 4; ++e) r[4 * n + e] = fsilu(acc[ai][0][m][n][e] * rs) * (acc[ai][1][m][n][e] * rs);
                u32x4 w; w.x = cvt_pk_bf16(r[0], r[1]); w.y = cvt_pk_bf16(r[2], r[3]); w.z = cvt_pk_bf16(r[4], r[5]); w.w = cvt_pk_bf16(r[6], r[7]);
                *(u32x4*)(out + row * 2816 + col0) = w; }
    }
};

template <class Epi, class Sched, bool ALIGN_EPI = false, bool SP2 = false>
__device__ __forceinline__ void gemm_phase(PG8_LAS unsigned char* lds, const Gemm g, const Sched& S, const Epi& E) {
    const int tid = threadIdx.x, wid = __builtin_amdgcn_readfirstlane(tid >> 6), lane = tid & 63, wr = wid >> 2, wc = wid & 3, fr = lane & 15, fq = lane >> 4;
    const int K = g.K, nt = K / BK;
    unsigned voffA[2], voffB[2];
#pragma unroll
    for (int i = 0; i < 2; ++i) { int R, C; stage_rc(tid * 16 + i * 8192, R, C); const int Rb = Epi::PERM ? ((R & ~31) + perm32(R & 31)) : R;
        voffA[i] = (unsigned)(R * K + C) * 2u; voffB[i] = (unsigned)(Rb * K + C) * 2u; }
    const size_t kstep = (size_t)(BK * 2);
    const size_t hstep = (size_t)HALF * K * 2;
    const size_t tstep = 2 * hstep;
    const unsigned ldsw = (unsigned)wid * 1024u;
    const int aoff = lds_byte(wr * 64 + fr, fq * 8), boff = lds_byte(wc * 32 + fr, fq * 8);
#define PG8_SA(b, h) (((b) * 2 + (h)) * HTB)
#define PG8_SB(b, h) ((4 + (b) * 2 + (h)) * HTB)
#define PG8_STAGE(bufoff, gbase, voff) do { _Pragma("unroll") for (int _i = 0; _i < 2; ++_i) \
        __builtin_amdgcn_global_load_lds((const unsigned*)((const char*)(gbase) + (voff)[_i]), (PG8_LAS unsigned*)(lds + (bufoff) + ldsw + _i * 8192), 16, 0, 0); } while (0)
#define PG8_LDA(dst, b, h) do { _Pragma("unroll") for (int m = 0; m < 4; ++m) _Pragma("unroll") for (int k = 0; k < 2; ++k) dst[m][k] = *(const PG8_LAS bf16x8*)(lds + PG8_SA(b, h) + aoff + m * 2048 + k * 1024); } while (0)
#define PG8_LDB(dst, b, h) do { _Pragma("unroll") for (int n = 0; n < 2; ++n) _Pragma("unroll") for (int k = 0; k < 2; ++k) dst[n][k] = *(const PG8_LAS bf16x8*)(lds + PG8_SB(b, h) + boff + n * 2048 + k * 1024); } while (0)
#define PG8_MMA(ai, bj, At, Bt) do { __builtin_amdgcn_s_setprio(1); _Pragma("unroll") for (int m = 0; m < 4; ++m) _Pragma("unroll") for (int n = 0; n < 2; ++n) _Pragma("unroll") for (int k = 0; k < 2; ++k) \
        acc[ai][bj][m][n] = __builtin_amdgcn_mfma_f32_16x16x32_bf16(Bt[n][k], At[m][k], acc[ai][bj][m][n], 0, 0, 0); __builtin_amdgcn_s_setprio(0); } while (0)
#define PG8_WAIT_V(n) asm volatile("s_waitcnt vmcnt(" #n ")" ::: "memory")
#define PG8_WAIT_L(n) asm volatile("s_waitcnt lgkmcnt(" #n ")" ::: "memory")
#define PG8_BAR __builtin_amdgcn_s_barrier()
#define PG8_SCHED __builtin_amdgcn_sched_barrier(0)
    Unit cur, nxt; int ui = 0;
    if (!S.next(0, cur)) return;
    f32x4 acc[2][2][4][2];
#pragma unroll
    for (int a = 0; a < 2; ++a)
#pragma unroll
        for (int b = 0; b < 2; ++b)
#pragma unroll
            for (int m = 0; m < 4; ++m)
#pragma unroll
                for (int n = 0; n < 2; ++n) acc[a][b][m][n] = (f32x4){0.f, 0.f, 0.f, 0.f};
    bf16x8 At[4][2], B0[2][2], B1[2][2];
    const char* cA = (const char*)g.A + (size_t)cur.pm * tstep; const char* cB = (const char*)g.Bt + (size_t)cur.pn * tstep;
    S.a_ready(cur);
    if constexpr (SP2) {
        PG8_STAGE(PG8_SB(0, 0), cB, voffB); PG8_STAGE(PG8_SB(0, 1), cB + hstep, voffB); PG8_STAGE(PG8_SA(0, 0), cA, voffA); PG8_STAGE(PG8_SA(0, 1), cA + hstep, voffA);
        if (wr == 1) PG8_BAR;
        PG8_WAIT_V(2); PG8_BAR;
        PG8_STAGE(PG8_SB(1, 0), cB + kstep, voffB); PG8_STAGE(PG8_SA(1, 0), cA + kstep, voffA); PG8_STAGE(PG8_SB(1, 1), cB + hstep + kstep, voffB);
        PG8_WAIT_V(6); PG8_BAR;
    } else {
        PG8_STAGE(PG8_SB(0, 0), cB, voffB); PG8_STAGE(PG8_SA(0, 0), cA, voffA); PG8_STAGE(PG8_SB(0, 1), cB + hstep, voffB); PG8_STAGE(PG8_SA(0, 1), cA + hstep, voffA);
        if (wr == 1) PG8_BAR;
        PG8_WAIT_V(4); PG8_BAR;
        PG8_STAGE(PG8_SB(1, 0), cB + kstep, voffB); PG8_STAGE(PG8_SA(1, 0), cA + kstep, voffA); PG8_STAGE(PG8_SB(1, 1), cB + hstep + kstep, voffB);
        PG8_WAIT_V(6); PG8_BAR;
    }
    for (;;) {
        const bool has_next = S.next(ui + 1, nxt);
        const char* nA = has_next ? (const char*)g.A + (size_t)nxt.pm * tstep : cA; const char* nB = has_next ? (const char*)g.Bt + (size_t)nxt.pn * tstep : cB;
        for (int t = 0; t < nt; t += 2) {
            const bool last = (t == nt - 2);
            const char* a1 = cA + (size_t)(t + 1) * kstep;
            const char* a2 = last ? nA : cA + (size_t)(t + 2) * kstep; const char* b2 = last ? nB : cB + (size_t)(t + 2) * kstep;
            const char* a3 = a2 + kstep; const char* b3 = b2 + kstep;
            if (last && has_next) S.a_ready(nxt);
            if constexpr (SP2) {
            PG8_LDB(B0, 0, 0); PG8_LDB(B1, 0, 1); PG8_SCHED; PG8_LDA(At, 0, 0); PG8_STAGE(PG8_SA(1, 1), a1 + hstep, voffA);
            PG8_WAIT_V(8); PG8_WAIT_L(0); PG8_BAR; PG8_MMA(0, 0, At, B0); PG8_MMA(0, 1, At, B1); PG8_BAR; PG8_SCHED;
            PG8_LDA(At, 0, 1); PG8_STAGE(PG8_SB(0, 0), b2, voffB); PG8_STAGE(PG8_SB(0, 1), b2 + hstep, voffB); PG8_STAGE(PG8_SA(0, 0), a2, voffA);
            PG8_WAIT_V(8); PG8_WAIT_L(0); PG8_BAR; PG8_MMA(1, 0, At, B0); PG8_MMA(1, 1, At, B1); PG8_BAR; PG8_SCHED;
            PG8_LDB(B0, 1, 0); PG8_LDB(B1, 1, 1); PG8_SCHED; PG8_LDA(At, 1, 0); PG8_STAGE(PG8_SA(0, 1), a2 + hstep, voffA);
            PG8_WAIT_V(8); PG8_WAIT_L(0); PG8_BAR; PG8_MMA(0, 0, At, B0); PG8_MMA(0, 1, At, B1); PG8_BAR; PG8_SCHED;
            PG8_LDA(At, 1, 1); PG8_STAGE(PG8_SB(1, 0), b3, voffB); PG8_STAGE(PG8_SB(1, 1), b3 + hstep, voffB); PG8_STAGE(PG8_SA(1, 0), a3, voffA);
            PG8_WAIT_V(8); PG8_WAIT_L(0); PG8_BAR; PG8_MMA(1, 0, At, B0); PG8_MMA(1, 1, At, B1); PG8_BAR; PG8_SCHED;
            } else {
            PG8_LDB(B0, 0, 0); PG8_SCHED; PG8_LDA(At, 0, 0); PG8_STAGE(PG8_SA(1, 1), a1 + hstep, voffA);
            PG8_WAIT_L(8); PG8_BAR; PG8_WAIT_L(0); PG8_MMA(0, 0, At, B0); PG8_BAR; PG8_SCHED;
            PG8_LDB(B1, 0, 1); PG8_STAGE(PG8_SB(0, 0), b2, voffB);
            PG8_BAR; PG8_WAIT_L(0); PG8_MMA(0, 1, At, B1); PG8_BAR;
            PG8_LDA(At, 0, 1); PG8_STAGE(PG8_SA(0, 0), a2, voffA);
            PG8_BAR; PG8_WAIT_L(0); PG8_MMA(1, 0, At, B0); PG8_BAR; PG8_SCHED;
            PG8_STAGE(PG8_SB(0, 1), b2 + hstep, voffB);
            PG8_WAIT_V(6); PG8_BAR; PG8_MMA(1, 1, At, B1); PG8_BAR;
            PG8_LDB(B0, 1, 0); PG8_SCHED; PG8_LDA(At, 1, 0); PG8_STAGE(PG8_SA(0, 1), a2 + hstep, voffA);
            PG8_WAIT_L(8); PG8_BAR; PG8_WAIT_L(0); PG8_MMA(0, 0, At, B0); PG8_BAR; PG8_SCHED;
            PG8_LDB(B1, 1, 1); PG8_STAGE(PG8_SB(1, 0), b3, voffB);
            PG8_BAR; PG8_WAIT_L(0); PG8_MMA(0, 1, At, B1); PG8_BAR;
            PG8_LDA(At, 1, 1); PG8_STAGE(PG8_SA(1, 0), a3, voffA);
            PG8_BAR; PG8_WAIT_L(0); PG8_MMA(1, 0, At, B0); PG8_BAR; PG8_SCHED;
            PG8_STAGE(PG8_SB(1, 1), b3 + hstep, voffB);
            PG8_WAIT_V(6); PG8_BAR; PG8_MMA(1, 1, At, B1); PG8_BAR;
            }
        }
        if constexpr (ALIGN_EPI) { if (wr == 0) PG8_BAR; }
        if constexpr (!Epi::AFTER_DRAIN) { E(acc, cur, wr, wc, fr, fq); S.done(cur); }
        if (!has_next) break;
#pragma unroll
        for (int a = 0; a < 2; ++a)
#pragma unroll
            for (int b = 0; b < 2; ++b)
#pragma unroll
                for (int m = 0; m < 4; ++m)
#pragma unroll
                    for (int n = 0; n < 2; ++n) acc[a][b][m][n] = (f32x4){0.f, 0.f, 0.f, 0.f};
        cur = nxt; cA = nA; cB = nB; ++ui;
        if constexpr (ALIGN_EPI) { if (wr == 1) PG8_BAR; }
    }
    PG8_WAIT_V(0);
    if constexpr (!ALIGN_EPI) { if (wr == 0) PG8_BAR; }
    PG8_BAR;
    if constexpr (Epi::AFTER_DRAIN) { E.fused(acc, cur, wr, wc, fr, fq, lds, wid, lane); S.done(cur); }
#undef PG8_SA
#undef PG8_SB
#undef PG8_STAGE
#undef PG8_LDA
#undef PG8_LDB
#undef PG8_MMA
#undef PG8_WAIT_V
#undef PG8_WAIT_L
#undef PG8_BAR
#undef PG8_SCHED
}
}
#define LAS __attribute__((address_space(3)))
using pg8::bf16_t; using pg8::cvt_pk_bf16; using pg8::bf2f; using pg8::bflo; using pg8::bfhi; using pg8::fsigmoid; using pg8::fsilu; using pg8::RMS_EPS;
typedef short bf16x8 __attribute__((ext_vector_type(8)));
typedef short s16x4 __attribute__((ext_vector_type(4)));
typedef float f32x4 __attribute__((ext_vector_type(4)));
typedef float f32x16 __attribute__((ext_vector_type(16)));
typedef unsigned u32x4 __attribute__((ext_vector_type(4)));
typedef unsigned u32x2 __attribute__((ext_vector_type(2)));
#define MFMA32(a, b, c) __builtin_amdgcn_mfma_f32_32x32x16_bf16((a), (b), (c), 0, 0, 0)
#define MFMA16(a, b, c) __builtin_amdgcn_mfma_f32_16x16x32_bf16((a), (b), (c), 0, 0, 0)
#define DI __device__ __forceinline__
DI int crow(int reg, int h) { return (reg & 3) + 8 * (reg >> 2) + 4 * h; }
DI unsigned short f2bf(float f) { unsigned u = __float_as_uint(f); return (unsigned short)((u + 0x7fffu + ((u >> 16) & 1u)) >> 16); }
DI unsigned pk2(float lo, float hi) { return (unsigned)f2bf(lo) | ((unsigned)f2bf(hi) << 16); }
#define LDS_WAIT() asm volatile("s_waitcnt lgkmcnt(0)" ::: "memory")

constexpr int NWAVES = 8, NTHR = 512;
constexpr int BATCH = 2, T = 8192, D = 1024, M = BATCH * T, NMEM = 256, DFF = 2816;
constexpr size_t MiB = 1u << 20;
constexpr size_t WS_ROWSS1 = 0, WS_ROWSS2 = 65536, WS_ROWSS3 = 131072, CTL_ZERO_BYTES = 262144;
constexpr size_t WS_MEMN = 1 * MiB, WS_MK = 2 * MiB, WS_MVT = 3 * MiB;
constexpr size_t WS_WMAIN = 4 * MiB, WS_WSWAP = 13 * MiB, WS_WA = 15 * MiB, WS_WB = 16 * MiB, WS_WOUT = 17 * MiB, WS_WXQ = 19 * MiB, WS_WXK = 21 * MiB, WS_WXV = 23 * MiB,
                 WS_WXO = 25 * MiB, WS_WFI = 27 * MiB, WS_WFO = 38 * MiB;
constexpr size_t WS_QA = 44 * MiB, WS_GA = 60 * MiB, WS_LF = 76 * MiB, WS_VT = 108 * MiB, WS_GATE = 140 * MiB, WS_U = 204 * MiB, WS_YA = 236 * MiB, WS_GAM = 252 * MiB;
constexpr size_t WS_T1 = 44 * MiB, WS_MERGED = 76 * MiB, WS_X1B = 108 * MiB, WS_XQ = 44 * MiB, WS_XO = 76 * MiB, WS_X2B = 108 * MiB, WS_FFH = 140 * MiB;
constexpr size_t WS_END = 256 * MiB;
constexpr size_t DO_H1 = 0, DO_QB = 32 * MiB, DO_KB = 48 * MiB, DO_YB = 0;
constexpr int LDS_BYTES = 147456;

DI float wave_sum(float v) {
#pragma unroll
    for (int o = 1; o < 64; o <<= 1) v += __shfl_xor(v, o);
    return v;
}
DI void p0_transpose_item(const float* W, int K, int N, bf16_t* dst, const float* gk, LAS float* scr, int k0, int n0, int lane) {
#pragma unroll 8
    for (int i = 0; i < 32; ++i) { const int kk = 2 * i + (lane >> 5); float w = W[(size_t)(k0 + kk) * N + n0 + (lane & 31)]; if (gk) w *= gk[k0 + kk]; scr[kk * 33 + (lane & 31)] = w; }
    LDS_WAIT();
    const int c = lane & 7;
#pragma unroll
    for (int j = 0; j < 4; ++j) { const int n = (lane >> 3) + 8 * j; const LAS float* s = scr + (8 * c) * 33 + n;
        u32x4 o; o.x = pk2(s[0 * 33], s[1 * 33]); o.y = pk2(s[2 * 33], s[3 * 33]); o.z = pk2(s[4 * 33], s[5 * 33]); o.w = pk2(s[6 * 33], s[7 * 33]);
        *(u32x4*)(dst + (size_t)n * K + k0 + 8 * c) = o; }
    LDS_WAIT();
}
DI void rms_row_to_bf16(const float* xrow, const float* g, bf16_t* orow, int lane) {
    const f32x4* xr = (const f32x4*)xrow + lane; const f32x4* gr = (const f32x4*)g + lane;
    f32x4 v[4]; float s = 0.f;
#pragma unroll
    for (int j = 0; j < 4; ++j) { v[j] = xr[64 * j]; s += (v[j].x * v[j].x + v[j].y * v[j].y) + (v[j].z * v[j].z + v[j].w * v[j].w); }
    const float rstd = rsqrtf(wave_sum(s) * (1.f / 1024.f) + RMS_EPS);
    unsigned long long* o8 = (unsigned long long*)orow + lane;
#pragma unroll
    for (int j = 0; j < 4; ++j) { const f32x4 gg = gr[64 * j];
        o8[64 * j] = (unsigned long long)pk2(v[j].x * rstd * gg.x, v[j].y * rstd * gg.y) | ((unsigned long long)pk2(v[j].z * rstd * gg.z, v[j].w * rstd * gg.w) << 32); }
}

DI void hgrn_a_item(LAS unsigned char* lds, int item, const float* LF, const bf16_t* VT, bf16_t* U, float* GAM) {
    const int tid = threadIdx.x, lane = tid & 63, wave = tid >> 6;
    const int bh = item >> 7, c = item & 127, b = bh >> 2, h = bh & 3;
    const size_t row0 = (size_t)b * T + c * 64;
    LAS float* PT = (LAS float*)(lds + 32768);
    LAS bf16_t* KT = (LAS bf16_t*)(lds + 34816);
    const int d = tid & 127, part = tid >> 7;
    float lf[16], bb[16];
#pragma unroll
    for (int j = 0; j < 16; ++j) lf[j] = LF[(row0 + part * 16 + j) * 512 + h * 128 + d];
    float run = 0.f;
#pragma unroll
    for (int j = 0; j < 16; ++j) { run += lf[j]; bb[j] = run; }
    PT[part * 128 + d] = run;
    __syncthreads();
    float off = 0.f, tot = 0.f;
#pragma unroll
    for (int p = 0; p < 4; ++p) { const float v = PT[p * 128 + d]; if (p < part) off += v; tot += v; }
    unsigned pk[8];
#pragma unroll
    for (int j = 0; j < 16; j += 2) { const float k0 = (1.f - __expf(lf[j])) * __expf(tot - (bb[j] + off)), k1 = (1.f - __expf(lf[j + 1])) * __expf(tot - (bb[j + 1] + off)); pk[j >> 1] = cvt_pk_bf16(k0, k1); }
    LAS u32x4* dst = (LAS u32x4*)(KT + d * 72 + part * 16);
    dst[0] = (u32x4){pk[0], pk[1], pk[2], pk[3]}; dst[1] = (u32x4){pk[4], pk[5], pk[6], pk[7]};
    if (part == 0) GAM[(size_t)item * 128 + d] = __expf(tot);
    __syncthreads();
    const int r = lane & 31, hh = lane >> 5, mt = wave >> 1, ntb = (wave & 1) * 2;
    f32x16 acc0, acc1;
#pragma unroll
    for (int i = 0; i < 16; ++i) { acc0[i] = 0.f; acc1[i] = 0.f; }
    const bf16_t* vrow = VT + (size_t)(h * 128 + mt * 32 + r) * M + row0 + 8 * hh;
#pragma unroll
    for (int s = 0; s < 4; ++s) { const bf16x8 a = *(const bf16x8*)(vrow + 16 * s);
        const bf16x8 b0 = *(const LAS bf16x8*)(KT + (ntb * 32 + r) * 72 + 16 * s + 8 * hh), b1 = *(const LAS bf16x8*)(KT + ((ntb + 1) * 32 + r) * 72 + 16 * s + 8 * hh);
        acc0 = MFMA32(a, b0, acc0); acc1 = MFMA32(a, b1, acc1); }
    bf16_t* up = U + (size_t)item * 16384;
#pragma unroll
    for (int i = 0; i < 16; ++i) { const int v = mt * 32 + crow(i, hh); up[v * 128 + ntb * 32 + r] = f2bf(acc0[i]); up[v * 128 + (ntb + 1) * 32 + r] = f2bf(acc1[i]); }
    __syncthreads();
}
DI void hgrn_scan(bf16_t* U, const float* GAM, int G) {
    const int tid = threadIdx.x;
    if (tid >= 256) return;
    for (int e = blockIdx.x * 256 + tid; e < 65536; e += G * 256) {
        const int bh = e >> 13, rem = e & 8191;
        float s0 = 0.f, s1 = 0.f;
        unsigned* up = (unsigned*)(U + (size_t)bh * 128 * 16384) + rem;
        const float* gp = GAM + (size_t)bh * 128 * 128 + ((rem * 2) & 127);
        for (int c0 = 0; c0 < 128; c0 += 8) {
            unsigned uu[8]; float g0[8], g1[8];
#pragma unroll
            for (int j = 0; j < 8; ++j) { uu[j] = up[(size_t)(c0 + j) * 8192]; g0[j] = gp[(c0 + j) * 128]; g1[j] = gp[(c0 + j) * 128 + 1]; }
#pragma unroll
            for (int j = 0; j < 8; ++j) { up[(size_t)(c0 + j) * 8192] = pk2(s0, s1); s0 = g0[j] * s0 + bflo(uu[j]); s1 = g1[j] * s1 + bfhi(uu[j]); }
        }
    }
}
DI void hgrn_e_item(LAS unsigned char* lds, int item, const float* LF, const bf16_t* QA, const bf16_t* GA, const bf16_t* VT, const bf16_t* SST, const float* g_hgrn, bf16_t* YA) {
    const int tid = threadIdx.x, lane = tid & 63, wave = tid >> 6;
    const int bh = item >> 7, c = item & 127, b = bh >> 2, h = bh & 3;
    const size_t row0 = (size_t)b * T + c * 64;
    LAS float* PT = (LAS float*)(lds + 32768);
    LAS bf16_t* QT = (LAS bf16_t*)(lds + 34816);
    LAS bf16_t* QD = (LAS bf16_t*)(lds + 52224);
    LAS bf16_t* KD = (LAS bf16_t*)(lds + 69632);
    LAS bf16_t* SC = (LAS bf16_t*)(lds + 113152);
    LAS float* SSQ = (LAS float*)(lds + 122368);
    const int d = tid & 127, part = tid >> 7;
    float lf[16], bb[16];
#pragma unroll
    for (int j = 0; j < 16; ++j) lf[j] = LF[(row0 + part * 16 + j) * 512 + h * 128 + d];
    float run = 0.f;
#pragma unroll
    for (int j = 0; j < 16; ++j) { run += lf[j]; bb[j] = run; }
    PT[part * 128 + d] = run;
    for (int u = tid; u < 2304; u += NTHR) ((LAS unsigned*)SC)[u] = 0u;
    __syncthreads();
    const float B1 = PT[d], B2 = B1 + PT[128 + d], B3 = B2 + PT[256 + d];
    const float off = part == 0 ? 0.f : (part == 1 ? B1 : (part == 2 ? B2 : B3));
#pragma unroll
    for (int j = 0; j < 16; ++j) {
        const int t = part * 16 + j; const float bt = bb[j] + off;
        const float q = bf2f(QA[(row0 + t) * 512 + h * 128 + d]);
        QT[t * 136 + d] = f2bf(q * __expf(bt)); QD[t * 136 + d] = f2bf(q * __expf(bb[j]));
        const float k = 1.f - __expf(lf[j]);
#pragma unroll
        for (int ip = 0; ip < 4; ++ip) if (ip >= part) { const float beta = ip == 0 ? 0.f : (ip == 1 ? B1 : (ip == 2 ? B2 : B3));
            KD[(8 * ip * (ip + 1) + t) * 136 + d] = f2bf(k * __expf(beta - bt)); }
    }
    __syncthreads();
    for (int tile = wave; tile < 10; tile += 8) {
        const int i = tile >= 6 ? 3 : (tile >= 3 ? 2 : (tile >= 1 ? 1 : 0)), j = tile - (i * (i + 1)) / 2, base = 8 * i * (i + 1);
        const int r16 = lane & 15, q4 = lane >> 4;
        f32x4 sc = {0.f, 0.f, 0.f, 0.f};
#pragma unroll
        for (int s = 0; s < 4; ++s) { const bf16x8 a = *(const LAS bf16x8*)(QD + (16 * i + r16) * 136 + 32 * s + 8 * q4), bq = *(const LAS bf16x8*)(KD + (base + 16 * j + r16) * 136 + 32 * s + 8 * q4);
            sc = MFMA16(a, bq, sc); }
#pragma unroll
        for (int jj = 0; jj < 4; ++jj) { const int tl = 4 * q4 + jj; const bool ok = (j < i) || (r16 <= tl); SC[(16 * i + tl) * 72 + 16 * j + r16] = ok ? f2bf(sc[jj]) : (unsigned short)0; }
    }
    __syncthreads();
    const int mt = wave >> 2, nt = wave & 3, r = lane & 31, hh = lane >> 5;
    f32x16 o;
#pragma unroll
    for (int i = 0; i < 16; ++i) o[i] = 0.f;
    const bf16_t* sst = SST + (size_t)item * 16384 + (32 * nt + r) * 128 + 8 * hh;
#pragma unroll
    for (int s = 0; s < 8; ++s) { const bf16x8 a = *(const LAS bf16x8*)(QT + (32 * mt + r) * 136 + 16 * s + 8 * hh); const bf16x8 bs = *(const bf16x8*)(sst + 16 * s); o = MFMA32(a, bs, o); }
    const bf16_t* vt = VT + (size_t)(h * 128 + 32 * nt + r) * M + row0 + 8 * hh;
#pragma unroll
    for (int s = 0; s < 4; ++s) { const bf16x8 a = *(const LAS bf16x8*)(SC + (32 * mt + r) * 72 + 16 * s + 8 * hh); const bf16x8 bv = *(const bf16x8*)(vt + 16 * s); o = MFMA32(a, bv, o); }
#pragma unroll
    for (int i = 0; i < 16; ++i) { float s = o[i] * o[i];
        s += __shfl_xor(s, 1); s += __shfl_xor(s, 2); s += __shfl_xor(s, 4); s += __shfl_xor(s, 8); s += __shfl_xor(s, 16);
        if (r == 0) SSQ[(32 * mt + crow(i, hh)) * 4 + nt] = s; }
    __syncthreads();
    const int v = 32 * nt + r; const float gh = g_hgrn[h * 128 + v];
#pragma unroll
    for (int i = 0; i < 16; ++i) { const int t = 32 * mt + crow(i, hh);
        const float ss = (SSQ[t * 4] + SSQ[t * 4 + 1]) + (SSQ[t * 4 + 2] + SSQ[t * 4 + 3]); const float rstd = rsqrtf(ss * (1.f / 128.f) + RMS_EPS);
        const size_t off2 = (row0 + t) * 512 + h * 128 + v;
        YA[off2] = f2bf(o[i] * rstd * gh * bf2f(GA[off2])); }
    __syncthreads();
}
DI void sb_wave_item(LAS unsigned char* wl, int wi, const bf16_t* QB, const bf16_t* KB, const bf16_t* VT, bf16_t* YB) {
    const int lane = threadIdx.x & 63, r = lane & 31, hh = lane >> 5;
    const int b = wi >> 11, h = (wi >> 8) & 7, qb = wi & 255, t0 = qb * 32;
    const size_t rowb = (size_t)b * T;
    bf16x8 qf[4];
    { const bf16_t* qp = QB + (rowb + t0 + r) * 512 + h * 64 + 8 * hh;
#pragma unroll
      for (int s = 0; s < 4; ++s) qf[s] = *(const bf16x8*)(qp + 16 * s); }
    f32x16 o0, o1;
#pragma unroll
    for (int i = 0; i < 16; ++i) { o0[i] = 0.f; o1[i] = 0.f; }
    float carry = 0.f;
    const bf16_t* vt0 = VT + (size_t)(512 + h * 64 + r) * M + rowb + 4 * hh; const bf16_t* vt1 = vt0 + (size_t)32 * M;
    for (int kt = qb; kt >= 0; --kt) {
        const int key0 = kt * 32;
        const bf16_t* kp = KB + (rowb + key0 + r) * 512 + h * 64 + 8 * hh;
        f32x16 z;
#pragma unroll
        for (int i = 0; i < 16; ++i) z[i] = 0.f;
#pragma unroll
        for (int s = 0; s < 4; ++s) z = MFMA32(*(const bf16x8*)(kp + 16 * s), qf[s], z);
        s16x4 va0[2][2], va1[2][2];
#pragma unroll
        for (int s = 0; s < 2; ++s)
#pragma unroll
            for (int hf = 0; hf < 2; ++hf) { va0[s][hf] = *(const s16x4*)(vt0 + key0 + 16 * s + 8 * hf); va1[s][hf] = *(const s16x4*)(vt1 + key0 + 16 * s + 8 * hf); }
        const bool diag = (kt == qb);
        float sp[16];
#pragma unroll
        for (int i = 0; i < 16; ++i) { const float zi = z[i]; const bool valid = !diag || (crow(i, hh) < r);
            const float spv = fmaxf(zi, 0.f) + __logf(1.f + __expf(-fabsf(zi))); sp[i] = valid ? spv : 0.f; }
        float Gs[4], PG[4];
#pragma unroll
        for (int g = 0; g < 4; ++g) { Gs[g] = (sp[4 * g] + sp[4 * g + 1]) + (sp[4 * g + 2] + sp[4 * g + 3]); PG[g] = __shfl_xor(Gs[g], 32); }
        float R[4]; R[3] = 0.f; R[2] = Gs[3] + PG[3]; R[1] = R[2] + (Gs[2] + PG[2]); R[0] = R[1] + (Gs[1] + PG[1]);
        const float tot = R[0] + (Gs[0] + PG[0]);
        float av[16];
#pragma unroll
        for (int g = 0; g < 4; ++g) { const float after = carry + R[g] + (hh == 0 ? PG[g] : 0.f);
            float ins = 0.f;
#pragma unroll
            for (int e = 3; e >= 0; --e) { const int i = 4 * g + e; ins += sp[i]; const bool valid = !diag || (crow(i, hh) < r);
                av[i] = valid ? __expf(z[i] - (after + ins)) : 0.f; } }
        carry += tot;
        u32x4 p0, p1;
        p0.x = cvt_pk_bf16(av[0], av[1]); p0.y = cvt_pk_bf16(av[2], av[3]); p0.z = cvt_pk_bf16(av[4], av[5]); p0.w = cvt_pk_bf16(av[6], av[7]);
        p1.x = cvt_pk_bf16(av[8], av[9]); p1.y = cvt_pk_bf16(av[10], av[11]); p1.z = cvt_pk_bf16(av[12], av[13]); p1.w = cvt_pk_bf16(av[14], av[15]);
        const bf16x8 pb0 = __builtin_bit_cast(bf16x8, p0), pb1 = __builtin_bit_cast(bf16x8, p1);
        o0 = MFMA32(__builtin_shufflevector(va0[0][0], va0[0][1], 0, 1, 2, 3, 4, 5, 6, 7), pb0, o0);
        o0 = MFMA32(__builtin_shufflevector(va0[1][0], va0[1][1], 0, 1, 2, 3, 4, 5, 6, 7), pb1, o0);
        o1 = MFMA32(__builtin_shufflevector(va1[0][0], va1[0][1], 0, 1, 2, 3, 4, 5, 6, 7), pb0, o1);
        o1 = MFMA32(__builtin_shufflevector(va1[1][0], va1[1][1], 0, 1, 2, 3, 4, 5, 6, 7), pb1, o1);
        if (__all(carry > 104.f)) break;
    }
    LAS bf16_t* OL = (LAS bf16_t*)wl;
#pragma unroll
    for (int i = 0; i < 16; ++i) { OL[r * 72 + crow(i, hh)] = f2bf(o0[i]); OL[r * 72 + 32 + crow(i, hh)] = f2bf(o1[i]); }
    LDS_WAIT();
    { const int row = lane >> 1, half = lane & 1; bf16_t* gp = YB + (rowb + t0 + row) * 512 + h * 64 + half * 32;
#pragma unroll
      for (int k = 0; k < 4; ++k) *(u32x4*)(gp + 8 * k) = *(const LAS u32x4*)(OL + row * 72 + half * 32 + 8 * k); }
    LDS_WAIT();
}
DI void xattn_item(LAS unsigned char* lds, int item, const bf16_t* XQ, const bf16_t* MK, const bf16_t* MVT, bf16_t* XO) {
    const int tid = threadIdx.x, lane = tid & 63, wave = tid >> 6, r = lane & 31, hh = lane >> 5;
    const int b = item >> 7, h = (item >> 5) & 3, tile = item & 31;
    const size_t rowq = (size_t)b * T + tile * 256 + wave * 32;
    bf16x8 qf[16];
    { const bf16_t* qp = XQ + (rowq + r) * 1024 + h * 256 + 8 * hh;
#pragma unroll
      for (int s = 0; s < 16; ++s) qf[s] = *(const bf16x8*)(qp + 16 * s); }
    f32x16 S[8];
#pragma unroll
    for (int mt = 0; mt < 8; ++mt) {
#pragma unroll
        for (int i = 0; i < 16; ++i) S[mt][i] = 0.f;
        const bf16_t* kp = MK + (size_t)(b * NMEM + 32 * mt + r) * 1024 + h * 256 + 8 * hh;
#pragma unroll
        for (int s = 0; s < 16; ++s) S[mt] = MFMA32(*(const bf16x8*)(kp + 16 * s), qf[s], S[mt]);
    }
    float mx = -3.0e38f;
#pragma unroll
    for (int mt = 0; mt < 8; ++mt)
#pragma unroll
        for (int i = 0; i < 16; ++i) mx = fmaxf(mx, S[mt][i]);
    mx = fmaxf(mx, __shfl_xor(mx, 32));
    float sum = 0.f;
    bf16x8 P[8][2];
#pragma unroll
    for (int mt = 0; mt < 8; ++mt) {
        float p[16];
#pragma unroll
        for (int i = 0; i < 16; ++i) { p[i] = __expf(S[mt][i] - mx); sum += p[i]; }
        u32x4 p0, p1;
        p0.x = cvt_pk_bf16(p[0], p[1]); p0.y = cvt_pk_bf16(p[2], p[3]); p0.z = cvt_pk_bf16(p[4], p[5]); p0.w = cvt_pk_bf16(p[6], p[7]);
        p1.x = cvt_pk_bf16(p[8], p[9]); p1.y = cvt_pk_bf16(p[10], p[11]); p1.z = cvt_pk_bf16(p[12], p[13]); p1.w = cvt_pk_bf16(p[14], p[15]);
        P[mt][0] = __builtin_bit_cast(bf16x8, p0); P[mt][1] = __builtin_bit_cast(bf16x8, p1);
    }
    sum += __shfl_xor(sum, 32);
    const float inv = 1.f / sum;
    LAS bf16_t* OL = (LAS bf16_t*)(lds + wave * 16896);
#pragma unroll
    for (int dt = 0; dt < 8; ++dt) {
        f32x16 O;
#pragma unroll
        for (int i = 0; i < 16; ++i) O[i] = 0.f;
        const bf16_t* vp = MVT + (size_t)(h * 256 + 32 * dt + r) * 512 + b * NMEM + 4 * hh;
#pragma unroll
        for (int mt = 0; mt < 8; ++mt)
#pragma unroll
            for (int s = 0; s < 2; ++s) { const s16x4 lo = *(const s16x4*)(vp + 32 * mt + 16 * s), hi = *(const s16x4*)(vp + 32 * mt + 16 * s + 8);
                O = MFMA32(__builtin_shufflevector(lo, hi, 0, 1, 2, 3, 4, 5, 6, 7), P[mt][s], O); }
#pragma unroll
        for (int i = 0; i < 16; ++i) OL[r * 264 + 32 * dt + crow(i, hh)] = f2bf(O[i] * inv);
    }
    LDS_WAIT();
#pragma unroll
    for (int k = 0; k < 16; ++k) { const int chunk = k * 64 + lane, row = chunk >> 5, c16 = chunk & 31;
        *(u32x4*)(XO + (rowq + row) * 1024 + h * 256 + c16 * 8) = *(const LAS u32x4*)(OL + row * 264 + c16 * 8); }
    LDS_WAIT();
}

constexpr int NPHASE = 13;
struct Args { const float* in[19]; float* out; unsigned char* ws; int ph_lo, ph_hi; };
#ifndef MK_ONE_LAUNCH
#define MK_ONE_LAUNCH 1
#endif

__global__ void __launch_bounds__(NTHR, 2) fwd_kernel(Args args) {
    extern __shared__ __attribute__((aligned(16))) unsigned char lds_raw[];
    LAS unsigned char* lds = (LAS unsigned char*)lds_raw;
    const int tid = threadIdx.x, lane = tid & 63, wave = __builtin_amdgcn_readfirstlane(tid >> 6);
    const int G = gridDim.x, bx = blockIdx.x;
    unsigned char* ws = args.ws; unsigned char* dob = (unsigned char*)args.out;
    const float* x = args.in[0]; const float* mem = args.in[1]; const float* g_mix = args.in[2]; const float* w_in = args.in[3]; const float* lb_table = args.in[4];
    const float* g_hgrn = args.in[5]; const float* w_gate = args.in[6]; const float* w_pa = args.in[7]; const float* w_pb = args.in[8]; const float* w_out = args.in[9];
    const float* g_xattn = args.in[10]; const float* g_mem = args.in[11]; const float* w_xq = args.in[12]; const float* w_xkv = args.in[13]; const float* w_xo = args.in[14];
    const float* g_ffn = args.in[15]; const float* w_ffn_in = args.in[16]; const float* w_ffn_out = args.in[17]; const float* g_final = args.in[18];
    float* ROWSS1 = (float*)(ws + WS_ROWSS1); float* ROWSS2 = (float*)(ws + WS_ROWSS2); float* ROWSS3 = (float*)(ws + WS_ROWSS3);
    bf16_t* MEMN = (bf16_t*)(ws + WS_MEMN); bf16_t* MK = (bf16_t*)(ws + WS_MK); bf16_t* MVT = (bf16_t*)(ws + WS_MVT);
    bf16_t* WMAIN = (bf16_t*)(ws + WS_WMAIN); bf16_t* WSWAP = (bf16_t*)(ws + WS_WSWAP); bf16_t* WA = (bf16_t*)(ws + WS_WA); bf16_t* WB = (bf16_t*)(ws + WS_WB);
    bf16_t* WOUT = (bf16_t*)(ws + WS_WOUT); bf16_t* WXQ = (bf16_t*)(ws + WS_WXQ); bf16_t* WXK = (bf16_t*)(ws + WS_WXK); bf16_t* WXV = (bf16_t*)(ws + WS_WXV);
    bf16_t* WXO = (bf16_t*)(ws + WS_WXO); bf16_t* WFI = (bf16_t*)(ws + WS_WFI); bf16_t* WFO = (bf16_t*)(ws + WS_WFO);
    bf16_t* QA = (bf16_t*)(ws + WS_QA); bf16_t* GA = (bf16_t*)(ws + WS_GA); float* LF = (float*)(ws + WS_LF); bf16_t* VT = (bf16_t*)(ws + WS_VT);
    bf16_t* GATE = (bf16_t*)(ws + WS_GATE); bf16_t* U = (bf16_t*)(ws + WS_U); bf16_t* YA = (bf16_t*)(ws + WS_YA); float* GAM = (float*)(ws + WS_GAM);
    bf16_t* T1 = (bf16_t*)(ws + WS_T1); bf16_t* MERGED = (bf16_t*)(ws + WS_MERGED); bf16_t* X1B = (bf16_t*)(ws + WS_X1B); bf16_t* XQ = (bf16_t*)(ws + WS_XQ);
    bf16_t* XO = (bf16_t*)(ws + WS_XO); bf16_t* X2B = (bf16_t*)(ws + WS_X2B); bf16_t* FFH = (bf16_t*)(ws + WS_FFH);
    bf16_t* H1 = (bf16_t*)(dob + DO_H1); bf16_t* QB = (bf16_t*)(dob + DO_QB); bf16_t* KB = (bf16_t*)(dob + DO_KB); bf16_t* YB = (bf16_t*)(dob + DO_YB);
    float* XR = args.out;

    const int lo = args.ph_lo, hi = args.ph_hi;
#define IN(k) (lo <= (k) && (k) < hi)
#define SEAM(k) do { if (IN(k) && IN((k) + 1)) cg::this_grid().sync(); } while (0)

    if (IN(0)) {
        LAS float* scr = (LAS float*)(lds + wave * 16384);
        const int gw = bx * NWAVES + wave, NGW = G * NWAVES;
        constexpr int I_IN = 16 * 112, I_GATE = 16 * 64, I_A = 8 * 32, I_B = 8 * 32, I_OUT = 16 * 32, I_XQ = 16 * 32, I_XKV = 16 * 64, I_XO = 16 * 32, I_FI = 16 * 176, I_FO = 44 * 32;
        constexpr int NITEMS = I_IN + I_GATE + I_A + I_B + I_OUT + I_XQ + I_XKV + I_XO + I_FI + I_FO;
        for (int it = gw; it < NITEMS; it += NGW) {
            int r = it;
            if (r < I_IN) { const int nblk = 112, k0 = 64 * (r / nblk), n0 = 32 * (r % nblk), seg = n0 >> 9;
                bf16_t* dst = (seg < 2) ? WMAIN + (size_t)n0 * 1024 : (seg == 2) ? WSWAP + (size_t)(n0 - 1024) * 1024 : (seg < 6) ? WMAIN + (size_t)(n0 - 512) * 1024 : WSWAP + (size_t)(n0 - 3072 + 512) * 1024;
                p0_transpose_item(w_in, 1024, 3584, dst, nullptr, scr, k0, n0, lane); continue; } r -= I_IN;
            if (r < I_GATE) { const int nblk = 64, k0 = 64 * (r / nblk), n0 = 32 * (r % nblk); p0_transpose_item(w_gate, 1024, 2048, WMAIN + (size_t)(2560 + n0) * 1024, nullptr, scr, k0, n0, lane); continue; } r -= I_GATE;
            if (r < I_A) { const int nblk = 32, k0 = 64 * (r / nblk), n0 = 32 * (r % nblk); p0_transpose_item(w_pa, 512, 1024, WA + (size_t)n0 * 512, nullptr, scr, k0, n0, lane); continue; } r -= I_A;
            if (r < I_B) { const int nblk = 32, k0 = 64 * (r / nblk), n0 = 32 * (r % nblk); p0_transpose_item(w_pb, 512, 1024, WB + (size_t)n0 * 512, nullptr, scr, k0, n0, lane); continue; } r -= I_B;
            if (r < I_OUT) { const int nblk = 32, k0 = 64 * (r / nblk), n0 = 32 * (r % nblk); p0_transpose_item(w_out, 1024, 1024, WOUT + (size_t)n0 * 1024, nullptr, scr, k0, n0, lane); continue; } r -= I_OUT;
            if (r < I_XQ) { const int nblk = 32, k0 = 64 * (r / nblk), n0 = 32 * (r % nblk); p0_transpose_item(w_xq, 1024, 1024, WXQ + (size_t)n0 * 1024, g_xattn, scr, k0, n0, lane); continue; } r -= I_XQ;
            if (r < I_XKV) { const int nblk = 64, k0 = 64 * (r / nblk), n0 = 32 * (r % nblk);
                bf16_t* dst = n0 < 1024 ? WXK + (size_t)n0 * 1024 : WXV + (size_t)(n0 - 1024) * 1024;
                p0_transpose_item(w_xkv, 1024, 2048, dst, nullptr, scr, k0, n0, lane); continue; } r -= I_XKV;
            if (r < I_XO) { const int nblk = 32, k0 = 64 * (r / nblk), n0 = 32 * (r % nblk); p0_transpose_item(w_xo, 1024, 1024, WXO + (size_t)n0 * 1024, nullptr, scr, k0, n0, lane); continue; } r -= I_XO;
            if (r < I_FI) { const int nblk = 176, k0 = 64 * (r / nblk), n0 = 32 * (r % nblk); const int up = n0 >= DFF, j = up ? n0 - DFF : n0;
                p0_transpose_item(w_ffn_in, 1024, 2 * DFF, WFI + (size_t)(256 * (j >> 7) + 128 * up + (j & 127)) * 1024, g_ffn, scr, k0, n0, lane); continue; } r -= I_FI;
            { const int nblk = 32, k0 = 64 * (r / nblk), n0 = 32 * (r % nblk); p0_transpose_item(w_ffn_out, DFF, 1024, WFO + (size_t)n0 * DFF, nullptr, scr, k0, n0, lane); }
        }
        for (int m = gw; m < M + BATCH * NMEM; m += NGW) {
            if (m < M) rms_row_to_bf16(x + (size_t)m * D, g_mix, H1 + (size_t)m * D, lane);
            else rms_row_to_bf16(mem + (size_t)(m - M) * D, g_mem, MEMN + (size_t)(m - M) * D, lane);
        }
        __syncthreads();
    }
    SEAM(0);
    if (IN(1)) {
        { pg8::Gemm g{H1, WMAIN, M, 4608, 1024}; pg8::StaticOrder S; S.init(M, 4608, G, bx);
          pg8::EpiMain E{QA, GA, QB, KB, GATE, LF, lb_table};
          pg8::gemm_phase<pg8::EpiMain, pg8::StaticOrder, true, true>(lds, g, S, E); }
        { pg8::Gemm g{WSWAP, H1, 1024, M, 1024}; pg8::StaticOrder S; S.init(1024, M, G, bx);
          pg8::EpiStore E{VT, M};
          pg8::gemm_phase<pg8::EpiStore, pg8::StaticOrder, true, true>(lds, g, S, E); }
        { pg8::Gemm g{MEMN, WXK, BATCH * NMEM, 1024, 1024}; pg8::StaticOrder S; S.init(BATCH * NMEM, 1024, G, (bx + G - (128 % G)) % G);
          pg8::EpiStore E{MK, 1024};
          pg8::gemm_phase<pg8::EpiStore, pg8::StaticOrder, true, true>(lds, g, S, E); }
        { pg8::Gemm g{WXV, MEMN, 1024, BATCH * NMEM, 1024}; pg8::StaticOrder S; S.init(1024, BATCH * NMEM, G, (bx + G - (136 % G)) % G);
          pg8::EpiStore E{MVT, BATCH * NMEM};
          pg8::gemm_phase<pg8::EpiStore, pg8::StaticOrder, true, true>(lds, g, S, E); }
    }
    SEAM(1);
    if (IN(2)) {
        for (int item = bx; item < 1024; item += G) hgrn_a_item(lds, item, LF, VT, U, GAM);
        for (int wi = bx * NWAVES + wave; wi < 4096; wi += G * NWAVES) sb_wave_item(lds + wave * 4608, wi, QB, KB, VT, YB);
    }
    SEAM(2);
    if (IN(3)) hgrn_scan(U, GAM, G);
    SEAM(3);
    if (IN(4)) { for (int item = bx; item < 1024; item += G) hgrn_e_item(lds, item, LF, QA, GA, VT, U, g_hgrn, YA); }
    SEAM(4);
    if (IN(5)) {
        { pg8::Gemm g{YA, WA, M, 1024, 512}; pg8::StaticOrder S; S.init(M, 1024, G, bx);
          pg8::EpiGate E{GATE, nullptr, T1};
          pg8::gemm_phase<pg8::EpiGate, pg8::StaticOrder, true, true>(lds, g, S, E); }
        { pg8::Gemm g{YB, WB, M, 1024, 512}; pg8::StaticOrder S; S.init(M, 1024, G, bx);
          pg8::EpiGate E{GATE + 1024, T1, MERGED};
          pg8::gemm_phase<pg8::EpiGate, pg8::StaticOrder, true, true>(lds, g, S, E); }
    }
    SEAM(5);
    if (IN(6)) { pg8::Gemm g{MERGED, WOUT, M, 1024, 1024}; pg8::StaticOrder S; S.init(M, 1024, G, bx);
        pg8::EpiResid E{x, XR, X1B, ROWSS1};
        pg8::gemm_phase<pg8::EpiResid, pg8::StaticOrder, true, true>(lds, g, S, E); }
    SEAM(6);
    if (IN(7)) { pg8::Gemm g{X1B, WXQ, M, 1024, 1024}; pg8::StaticOrder S; S.init(M, 1024, G, bx);
        pg8::EpiRowScale E{ROWSS1, XQ, 0.0625f};
        pg8::gemm_phase<pg8::EpiRowScale, pg8::StaticOrder, true, true>(lds, g, S, E); }
    SEAM(7);
    if (IN(8)) { for (int item = bx; item < 256; item += G) { xattn_item(lds, item, XQ, MK, MVT, XO); __syncthreads(); } }
    SEAM(8);
    if (IN(9)) { pg8::Gemm g{XO, WXO, M, 1024, 1024}; pg8::StaticOrder S; S.init(M, 1024, G, bx);
        pg8::EpiResid E{XR, XR, X2B, ROWSS2};
        pg8::gemm_phase<pg8::EpiResid, pg8::StaticOrder, true, true>(lds, g, S, E); }
    SEAM(9);
    if (IN(10)) { pg8::Gemm g{X2B, WFI, M, 2 * DFF, 1024}; pg8::StaticOrder S; S.init(M, 2 * DFF, G, bx);
        pg8::EpiSwiglu E{ROWSS2, FFH};
        pg8::gemm_phase<pg8::EpiSwiglu, pg8::StaticOrder, true, true>(lds, g, S, E); }
    SEAM(10);
    if (IN(11)) { pg8::Gemm g{FFH, WFO, M, 1024, DFF}; pg8::StaticOrder S; S.init(M, 1024, G, bx);
        pg8::EpiResid E{XR, XR, nullptr, ROWSS3};
        pg8::gemm_phase<pg8::EpiResid, pg8::StaticOrder, true, true>(lds, g, S, E); }
    SEAM(11);
    if (IN(12)) {
        const int gw = bx * NWAVES + wave, NGW = G * NWAVES;
        for (int m = gw; m < M; m += NGW) {
            const float rstd = rsqrtf(ROWSS3[m] * (1.f / 1024.f) + RMS_EPS);
            f32x4* xr = (f32x4*)(XR + (size_t)m * D) + lane; const f32x4* gr = (const f32x4*)g_final + lane;
#pragma unroll
            for (int j = 0; j < 4; ++j) { f32x4 v = xr[64 * j]; const f32x4 gg = gr[64 * j]; v = v * rstd; v = v * gg; xr[64 * j] = v; }
        }
    }
#undef IN
#undef SEAM
}

extern "C" void kernel_launch(void* const* d_in, const int* in_sizes, int n_in, void* d_out, int out_size, void* d_ws, size_t ws_size, hipStream_t stream) {
    static int grid = 0;
    if (grid == 0) {
        if (n_in != 19 || out_size != M * D || ws_size < WS_END) { fprintf(stderr, "kernel_launch: unexpected shapes (n_in %d out %d ws %zu)\n", n_in, out_size, ws_size); grid = -1; return; }
        int dev = 0, cus = 0, per_cu = 0;
        hipGetDevice(&dev); hipDeviceGetAttribute(&cus, hipDeviceAttributeMultiprocessorCount, dev);
        hipFuncSetAttribute((const void*)fwd_kernel, hipFuncAttributeMaxDynamicSharedMemorySize, LDS_BYTES);
        hipOccupancyMaxActiveBlocksPerMultiprocessor(&per_cu, (const void*)fwd_kernel, NTHR, LDS_BYTES);
        if (per_cu < 1) { fprintf(stderr, "kernel_launch: occupancy query says %d blocks per CU\n", per_cu); per_cu = 1; }
        (void)hipGetLastError();
        grid = cus * per_cu;
        fprintf(stderr, "kernel_launch: grid %d (cus %d x %d)\n", grid, cus, per_cu);
    }
    if (grid < 0) return;
    hipMemsetAsync((char*)d_ws, 0, CTL_ZERO_BYTES, stream);
    Args a{};
    for (int i = 0; i < 19; ++i) a.in[i] = (const float*)d_in[i];
    a.out = (float*)d_out; a.ws = (unsigned char*)d_ws;
#if MK_ONE_LAUNCH
    a.ph_lo = 0; a.ph_hi = NPHASE;
    void* kargs[] = {&a};
    hipError_t e = hipLaunchCooperativeKernel((const void*)fwd_kernel, dim3(grid), dim3(NTHR), kargs, LDS_BYTES, stream);
    if (e != hipSuccess) fprintf(stderr, "cooperative launch failed: %s (grid %d)\n", hipGetErrorString(e), grid);
#else
    for (int p = 0; p < NPHASE; ++p) { a.ph_lo = p; a.ph_hi = p + 1; hipLaunchKernelGGL(fwd_kernel, dim3(grid), dim3(NTHR), LDS_BYTES, stream, a); }
#endif
}
```

```cpp
#include <hip/hip_runtime.h>
#include <hip/hip_cooperative_groups.h>
#include <cstdio>
#include <cstdint>
namespace cg = cooperative_groups;
namespace pg8 {
#define PG8_LAS __attribute__((address_space(3)))
typedef unsigned short bf16_t;
typedef short bf16x8 __attribute__((ext_vector_type(8)));
typedef float f32x4 __attribute__((ext_vector_type(4)));
typedef unsigned u32x4 __attribute__((ext_vector_type(4)));
constexpr int BM = 256, BK = 64, HALF = 128, HTB = HALF * BK * 2  , STAGE_BYTES = 8 * HTB, NXCD = 8, WGM = 8;

__host__ __device__ __forceinline__ int lds_byte(int r, int c) { const int st = (r >> 4) * 2 + (c >> 5), rr = r & 15, cc = c & 31, ob = rr * 64 + cc * 2; return st * 1024 + (ob ^ (((ob >> 9) & 1) << 5)); }
__host__ __device__ __forceinline__ void stage_rc(int b, int& R, int& C) { const int st = b / 1024, sb = b % 1024, swz = sb ^ (((sb >> 9) & 1) << 5); R = (st >> 1) * 16 + swz / 64; C = (st & 1) * 32 + (swz % 64) / 2; }
__host__ __device__ __forceinline__ int perm32(int rho) { const int n = rho >> 4, i = rho & 15; return 8 * (i >> 2) + 4 * n + (i & 3); }

struct Unit { int pm, pn; };
struct Gemm { const bf16_t* A; const bf16_t* Bt; int M, N, K; };

struct StaticOrder {
    int nM, nN, nwg, G, c;
    __host__ __device__ void init(int M, int N, int G_, int c_) { nM = M / BM; nN = N / BM; nwg = nM * nN; G = G_; c = c_; }
    __host__ __device__ bool next(int i, Unit& u) const {
        const long L = (long)i * G + c; if (L >= nwg) return false;
        int wgid = (int)L; { const int q = nwg / NXCD, r = nwg % NXCD, xcd = wgid % NXCD, off = wgid / NXCD; wgid = (xcd < r ? xcd * (q + 1) : r * (q + 1) + (xcd - r) * q) + off; }
        const int nig = WGM * nN, gid = wgid / nig, fm = gid * WGM, gsz = (nM - fm) < WGM ? (nM - fm) : WGM;
        u.pm = fm + ((wgid % nig) % gsz); u.pn = (wgid % nig) / gsz; return true;
    }
    __device__ __forceinline__ void a_ready(const Unit&) const {}
    __device__ __forceinline__ void done(const Unit&) const {}
};
typedef unsigned u32x2 __attribute__((ext_vector_type(2)));

__device__ __forceinline__ unsigned cvt_pk_bf16(float lo, float hi) { unsigned r; asm volatile("v_cvt_pk_bf16_f32 %0, %1, %2" : "=v"(r) : "v"(lo), "v"(hi)); return r; }
__device__ __forceinline__ float bf2f(unsigned short b) { return __uint_as_float((unsigned)b << 16); }
__device__ __forceinline__ float bflo(unsigned w) { return __uint_as_float(w << 16); }
__device__ __forceinline__ float bfhi(unsigned w) { return __uint_as_float(w & 0xffff0000u); }
__device__ __forceinline__ float fsigmoid(float x) { return __builtin_amdgcn_rcpf(1.f + __expf(-x)); }
__device__ __forceinline__ float fsilu(float x) { return x * fsigmoid(x); }
constexpr float RMS_EPS = 1e-6f;

struct EpiMain {
    static constexpr bool PERM = true, AFTER_DRAIN = false;
    bf16_t *QA, *GA, *QB, *KB, *GATE; float* LF; const float* lbt;
    __device__ __forceinline__ void operator()(const f32x4 (&acc)[2][2][4][2], const Unit& u, int wr, int wc, int fr, int fq) const {
        const int pn = u.pn; const int row0 = u.pm * BM + wr * 64 + fr; const int cin = wc * 32 + 8 * fq;
        if (pn == 2 || pn == 3) {
#pragma unroll
            for (int bj = 0; bj < 2; ++bj) {
                const int col = (pn - 2) * 256 + bj * HALF + cin;
                float lb[8];
#pragma unroll
                for (int e = 0; e < 8; ++e) { const float t0 = lbt[col + e], t1 = lbt[512 + col + e]; lb[e] = 1.f / (1.f + __expf(t1 - t0)); }
#pragma unroll
                for (int ai = 0; ai < 2; ++ai)
#pragma unroll
                    for (int m = 0; m < 4; ++m) {
                        float* p = LF + (size_t)(row0 + ai * HALF + m * 16) * 512 + col;
                        const f32x4 v0 = acc[ai][bj][m][0], v1 = acc[ai][bj][m][1]; f32x4 o0, o1;
#pragma unroll
                        for (int e = 0; e < 4; ++e) { o0[e] = __logf(lb[e] + (1.f - lb[e]) * fsigmoid(v0[e])); o1[e] = __logf(lb[4 + e] + (1.f - lb[4 + e]) * fsigmoid(v1[e])); }
                        *(f32x4*)p = o0; *(f32x4*)(p + 4) = o1;
                    }
            }
            return;
        }
        int mode; bf16_t* O; int ldc, colt;
        if (pn < 2) { mode = 1; O = QA; ldc = 512; colt = pn * 256; }
        else if (pn < 6) { mode = 1; O = GA; ldc = 512; colt = (pn - 4) * 256; }
        else if (pn < 8) { mode = 2; O = QB; ldc = 512; colt = (pn - 6) * 256; }
        else if (pn < 10) { mode = 0; O = KB; ldc = 512; colt = (pn - 8) * 256; }
        else { mode = 3; O = GATE; ldc = 2048; colt = (pn - 10) * 256; }
#pragma unroll
        for (int ai = 0; ai < 2; ++ai)
#pragma unroll
            for (int m = 0; m < 4; ++m) { bf16_t* rowp = O + (size_t)(row0 + ai * HALF + m * 16) * ldc + colt + cin;
#pragma unroll
                for (int bj = 0; bj < 2; ++bj) { f32x4 v0 = acc[ai][bj][m][0], v1 = acc[ai][bj][m][1];
                    if (mode == 1) {
#pragma unroll
                        for (int e = 0; e < 4; ++e) { v0[e] = fsilu(v0[e]); v1[e] = fsilu(v1[e]); } }
                    else if (mode == 2) { v0 = v0 * 0.125f; v1 = v1 * 0.125f; }
                    else if (mode == 3) {
#pragma unroll
                        for (int e = 0; e < 4; ++e) { v0[e] = fsigmoid(v0[e]); v1[e] = fsigmoid(v1[e]); } }
                    u32x4 w; w.x = cvt_pk_bf16(v0[0], v0[1]); w.y = cvt_pk_bf16(v0[2], v0[3]); w.z = cvt_pk_bf16(v1[0], v1[1]); w.w = cvt_pk_bf16(v1[2], v1[3]);
                    *(u32x4*)(rowp + bj * HALF) = w; } }
    }
};
struct EpiStore {
    static constexpr bool PERM = true, AFTER_DRAIN = false;
    bf16_t* O; int ldc;
    __device__ __forceinline__ void operator()(const f32x4 (&acc)[2][2][4][2], const Unit& u, int wr, int wc, int fr, int fq) const {
        const int row0 = u.pm * BM + wr * 64 + fr; const int col0 = u.pn * BM + wc * 32 + 8 * fq;
#pragma unroll
        for (int ai = 0; ai < 2; ++ai)
#pragma unroll
            for (int m = 0; m < 4; ++m) { bf16_t* rowp = O + (size_t)(row0 + ai * HALF + m * 16) * ldc + col0;
#pragma unroll
                for (int bj = 0; bj < 2; ++bj) { const f32x4 v0 = acc[ai][bj][m][0], v1 = acc[ai][bj][m][1];
                    u32x4 w; w.x = cvt_pk_bf16(v0[0], v0[1]); w.y = cvt_pk_bf16(v0[2], v0[3]); w.z = cvt_pk_bf16(v1[0], v1[1]); w.w = cvt_pk_bf16(v1[2], v1[3]);
                    *(u32x4*)(rowp + bj * HALF) = w; } }
    }
};
struct EpiGate {
    static constexpr bool PERM = true, AFTER_DRAIN = false;
    const bf16_t* gate; const bf16_t* addin; bf16_t* out;
    __device__ __forceinline__ void operator()(const f32x4 (&acc)[2][2][4][2], const Unit& u, int wr, int wc, int fr, int fq) const {
        const int row0 = u.pm * BM + wr * 64 + fr; const int col0 = u.pn * BM + wc * 32 + 8 * fq;
#pragma unroll
        for (int ai = 0; ai < 2; ++ai)
#pragma unroll
            for (int m = 0; m < 4; ++m) { const size_t row = (size_t)(row0 + ai * HALF + m * 16);
#pragma unroll
                for (int bj = 0; bj < 2; ++bj) { const f32x4 v0 = acc[ai][bj][m][0], v1 = acc[ai][bj][m][1]; const int col = col0 + bj * HALF;
                    const u32x4 g = *(const u32x4*)(gate + row * 2048 + col);
                    float r[8] = { bflo(g.x) * v0[0], bfhi(g.x) * v0[1], bflo(g.y) * v0[2], bfhi(g.y) * v0[3], bflo(g.z) * v1[0], bfhi(g.z) * v1[1], bflo(g.w) * v1[2], bfhi(g.w) * v1[3] };
                    if (addin) { const u32x4 t = *(const u32x4*)(addin + row * 1024 + col);
                        r[0] += bflo(t.x); r[1] += bfhi(t.x); r[2] += bflo(t.y); r[3] += bfhi(t.y); r[4] += bflo(t.z); r[5] += bfhi(t.z); r[6] += bflo(t.w); r[7] += bfhi(t.w); }
                    u32x4 w; w.x = cvt_pk_bf16(r[0], r[1]); w.y = cvt_pk_bf16(r[2], r[3]); w.z = cvt_pk_bf16(r[4], r[5]); w.w = cvt_pk_bf16(r[6], r[7]);
                    *(u32x4*)(out + row * 1024 + col) = w; } }
    }
};
struct EpiResid {
    static constexpr bool PERM = false, AFTER_DRAIN = false;
    const float* base; float* out; bf16_t* xb; float* rowss;
    __device__ __forceinline__ void operator()(const f32x4 (&acc)[2][2][4][2], const Unit& u, int wr, int wc, int fr, int fq) const {
        const int row0 = u.pm * BM + wr * 64 + fr; const int col0 = u.pn * BM + wc * 32 + 4 * fq;
#pragma unroll
        for (int ai = 0; ai < 2; ++ai)
#pragma unroll
            for (int m = 0; m < 4; ++m) { const size_t row = (size_t)(row0 + ai * HALF + m * 16); float ss = 0.f;
#pragma unroll
                for (int bj = 0; bj < 2; ++bj)
#pragma unroll
                    for (int n = 0; n < 2; ++n) { const size_t off = row * 1024 + col0 + bj * HALF + n * 16;
                        const f32x4 v = *(const f32x4*)(base + off) + acc[ai][bj][m][n];
                        *(f32x4*)(out + off) = v; ss += (v[0] * v[0] + v[1] * v[1]) + (v[2] * v[2] + v[3] * v[3]);
                        if (xb) { u32x2 w; w.x = cvt_pk_bf16(v[0], v[1]); w.y = cvt_pk_bf16(v[2], v[3]); *(u32x2*)(xb + off) = w; } }
                ss += __shfl_xor(ss, 16); ss += __shfl_xor(ss, 32);
                if (fq == 0) unsafeAtomicAdd(rowss + row, ss); }
    }
};
struct EpiRowScale {
    static constexpr bool PERM = true, AFTER_DRAIN = false;
    const float* rowss; bf16_t* out; float scale;
    __device__ __forceinline__ void operator()(const f32x4 (&acc)[2][2][4][2], const Unit& u, int wr, int wc, int fr, int fq) const {
        const int row0 = u.pm * BM + wr * 64 + fr; const int col0 = u.pn * BM + wc * 32 + 8 * fq;
#pragma unroll
        for (int ai = 0; ai < 2; ++ai)
#pragma unroll
            for (int m = 0; m < 4; ++m) { const size_t row = (size_t)(row0 + ai * HALF + m * 16); const float rs = rsqrtf(rowss[row] * (1.f / 1024.f) + RMS_EPS) * scale;
#pragma unroll
                for (int bj = 0; bj < 2; ++bj) { const f32x4 v0 = acc[ai][bj][m][0] * rs, v1 = acc[ai][bj][m][1] * rs;
                    u32x4 w; w.x = cvt_pk_bf16(v0[0], v0[1]); w.y = cvt_pk_bf16(v0[2], v0[3]); w.z = cvt_pk_bf16(v1[0], v1[1]); w.w = cvt_pk_bf16(v1[2], v1[3]);
                    *(u32x4*)(out + row * 1024 + col0 + bj * HALF) = w; } }
    }
};
struct EpiSwiglu {
    static constexpr bool PERM = true, AFTER_DRAIN = false;
    const float* rowss; bf16_t* out;
    __device__ __forceinline__ void operator()(const f32x4 (&acc)[2][2][4][2], const Unit& u, int wr, int wc, int fr, int fq) const {
        const int row0 = u.pm * BM + wr * 64 + fr; const int col0 = u.pn * HALF + wc * 32 + 8 * fq;
#pragma unroll
        for (int ai = 0; ai < 2; ++ai)
#pragma unroll
            for (int m = 0; m < 4; ++m) { const size_t row = (size_t)(row0 + ai * HALF + m * 16); const float rs = rsqrtf(rowss[row] * (1.f / 1024.f) + RMS_EPS);
                float r[8];
#pragma unroll
                for (int n = 0; n < 2; ++n)
#pragma unroll
                    for (int e = 0; e < 4; ++e) r[4 * n + e] = fsilu(acc[ai][0][m][n][e] * rs) * (acc[ai][1][m][n][e] * rs);
                u32x4 w; w.x = cvt_pk_bf16(r[0], r[1]); w.y = cvt_pk_bf16(r[2], r[3]); w.z = cvt_pk_bf16(r[4], r[5]); w.w = cvt_pk_bf16(r[6], r[7]);
                *(u32x4*)(out + row * 2816 + col0) = w; }
    }
};

template <class Epi, class Sched, bool ALIGN_EPI = false, bool SP2 = false>
__device__ __forceinline__ void gemm_phase(PG8_LAS unsigned char* lds, const Gemm g, const Sched& S, const Epi& E) {
    const int tid = threadIdx.x, wid = __builtin_amdgcn_readfirstlane(tid >> 6), lane = tid & 63, wr = wid >> 2, wc = wid & 3, fr = lane & 15, fq = lane >> 4;
    const int K = g.K, nt = K / BK;
    unsigned voffA[2], voffB[2];
#pragma unroll
    for (int i = 0; i < 2; ++i) { int R, C; stage_rc(tid * 16 + i * 8192, R, C); const int Rb = Epi::PERM ? ((R & ~31) + perm32(R & 31)) : R;
        voffA[i] = (unsigned)(R * K + C) * 2u; voffB[i] = (unsigned)(Rb * K + C) * 2u; }
    const size_t kstep = (size_t)(BK * 2);
    const size_t hstep = (size_t)HALF * K * 2;
    const size_t tstep = 2 * hstep;
    const unsigned ldsw = (unsigned)wid * 1024u;
    const int aoff = lds_byte(wr * 64 + fr, fq * 8), boff = lds_byte(wc * 32 + fr, fq * 8);
#define PG8_SA(b, h) (((b) * 2 + (h)) * HTB)
#define PG8_SB(b, h) ((4 + (b) * 2 + (h)) * HTB)
#define PG8_STAGE(bufoff, gbase, voff) do { _Pragma("unroll") for (int _i = 0; _i < 2; ++_i) \
        __builtin_amdgcn_global_load_lds((const unsigned*)((const char*)(gbase) + (voff)[_i]), (PG8_LAS unsigned*)(lds + (bufoff) + ldsw + _i * 8192), 16, 0, 0); } while (0)
#define PG8_LDA(dst, b, h) do { _Pragma("unroll") for (int m = 0; m < 4; ++m) _Pragma("unroll") for (int k = 0; k < 2; ++k) dst[m][k] = *(const PG8_LAS bf16x8*)(lds + PG8_SA(b, h) + aoff + m * 2048 + k * 1024); } while (0)
#define PG8_LDB(dst, b, h) do { _Pragma("unroll") for (int n = 0; n < 2; ++n) _Pragma("unroll") for (int k = 0; k < 2; ++k) dst[n][k] = *(const PG8_LAS bf16x8*)(lds + PG8_SB(b, h) + boff + n * 2048 + k * 1024); } while (0)
#define PG8_MMA(ai, bj, At, Bt) do { __builtin_amdgcn_s_setprio(1); _Pragma("unroll") for (int m = 0; m < 4; ++m) _Pragma("unroll") for (int n = 0; n < 2; ++n) _Pragma("unroll") for (int k = 0; k < 2; ++k) \
        acc[ai][bj][m][n] = __builtin_amdgcn_mfma_f32_16x16x32_bf16(Bt[n][k], At[m][k], acc[ai][bj][m][n], 0, 0, 0); __builtin_amdgcn_s_setprio(0); } while (0)
#define PG8_WAIT_V(n) asm volatile("s_waitcnt vmcnt(" #n ")" ::: "memory")
#define PG8_WAIT_L(n) asm volatile("s_waitcnt lgkmcnt(" #n ")" ::: "memory")
#define PG8_BAR __builtin_amdgcn_s_barrier()
#define PG8_SCHED __builtin_amdgcn_sched_barrier(0)
    Unit cur, nxt; int ui = 0;
    if (!S.next(0, cur)) return;
    f32x4 acc[2][2][4][2];
#pragma unroll
    for (int a = 0; a < 2; ++a)
#pragma unroll
        for (int b = 0; b < 2; ++b)
#pragma unroll
            for (int m = 0; m < 4; ++m)
#pragma unroll
                for (int n = 0; n < 2; ++n) acc[a][b][m][n] = (f32x4){0.f, 0.f, 0.f, 0.f};
    bf16x8 At[4][2], B0[2][2], B1[2][2];
    const char* cA = (const char*)g.A + (size_t)cur.pm * tstep; const char* cB = (const char*)g.Bt + (size_t)cur.pn * tstep;
    S.a_ready(cur);
    if constexpr (SP2) {
        PG8_STAGE(PG8_SB(0, 0), cB, voffB); PG8_STAGE(PG8_SB(0, 1), cB + hstep, voffB); PG8_STAGE(PG8_SA(0, 0), cA, voffA); PG8_STAGE(PG8_SA(0, 1), cA + hstep, voffA);
        if (wr == 1) PG8_BAR;
        PG8_WAIT_V(2); PG8_BAR;
        PG8_STAGE(PG8_SB(1, 0), cB + kstep, voffB); PG8_STAGE(PG8_SA(1, 0), cA + kstep, voffA); PG8_STAGE(PG8_SB(1, 1), cB + hstep + kstep, voffB);
        PG8_WAIT_V(6); PG8_BAR;
    } else {
        PG8_STAGE(PG8_SB(0, 0), cB, voffB); PG8_STAGE(PG8_SA(0, 0), cA, voffA); PG8_STAGE(PG8_SB(0, 1), cB + hstep, voffB); PG8_STAGE(PG8_SA(0, 1), cA + hstep, voffA);
        if (wr == 1) PG8_BAR;
        PG8_WAIT_V(4); PG8_BAR;
        PG8_STAGE(PG8_SB(1, 0), cB + kstep, voffB); PG8_STAGE(PG8_SA(1, 0), cA + kstep, voffA); PG8_STAGE(PG8_SB(1, 1), cB + hstep + kstep, voffB);
        PG8_WAIT_V(6); PG8_BAR;
    }
    for (;;) {
        const bool has_next = S.next(ui + 1, nxt);
        const char* nA = has_next ? (const char*)g.A + (size_t)nxt.pm * tstep : cA; const char* nB = has_next ? (const char*)g.Bt + (size_t)nxt.pn * tstep : cB;
        for (int t = 0; t < nt; t += 2) {
            const bool last = (t == nt - 2);
            const char* a1 = cA + (size_t)(t + 1) * kstep;
            const char* a2 = last ? nA : cA + (size_t)(t + 2) * kstep; const char* b2 = last ? nB : cB + (size_t)(t + 2) * kstep;
            const char* a3 = a2 + kstep; const char* b3 = b2 + kstep;
            if (last && has_next) S.a_ready(nxt);
            if constexpr (SP2) {
            PG8_LDB(B0, 0, 0); PG8_LDB(B1, 0, 1); PG8_SCHED; PG8_LDA(At, 0, 0); PG8_STAGE(PG8_SA(1, 1), a1 + hstep, voffA);
            PG8_WAIT_V(8); PG8_WAIT_L(0); PG8_BAR; PG8_MMA(0, 0, At, B0); PG8_MMA(0, 1, At, B1); PG8_BAR; PG8_SCHED;
            PG8_LDA(At, 0, 1); PG8_STAGE(PG8_SB(0, 0), b2, voffB); PG8_STAGE(PG8_SB(0, 1), b2 + hstep, voffB); PG8_STAGE(PG8_SA(0, 0), a2, voffA);
            PG8_WAIT_V(8); PG8_WAIT_L(0); PG8_BAR; PG8_MMA(1, 0, At, B0); PG8_MMA(1, 1, At, B1); PG8_BAR; PG8_SCHED;
            PG8_LDB(B0, 1, 0); PG8_LDB(B1, 1, 1); PG8_SCHED; PG8_LDA(At, 1, 0); PG8_STAGE(PG8_SA(0, 1), a2 + hstep, voffA);
            PG8_WAIT_V(8); PG8_WAIT_L(0); PG8_BAR; PG8_MMA(0, 0, At, B0); PG8_MMA(0, 1, At, B1); PG8_BAR; PG8_SCHED;
            PG8_LDA(At, 1, 1); PG8_STAGE(PG8_SB(1, 0), b3, voffB); PG8_STAGE(PG8_SB(1, 1), b3 + hstep, voffB); PG8_STAGE(PG8_SA(1, 0), a3, voffA);
            PG8_WAIT_V(8); PG8_WAIT_L(0); PG8_BAR; PG8_MMA(1, 0, At, B0); PG8_MMA(1, 1, At, B1); PG8_BAR; PG8_SCHED;
            } else {
            PG8_LDB(B0, 0, 0); PG8_SCHED; PG8_LDA(At, 0, 0); PG8_STAGE(PG8_SA(1, 1), a1 + hstep, voffA);
            PG8_WAIT_L(8); PG8_BAR; PG8_WAIT_L(0); PG8_MMA(0, 0, At, B0); PG8_BAR; PG8_SCHED;
            PG8_LDB(B1, 0, 1); PG8_STAGE(PG8_SB(0, 0), b2, voffB);
            PG8_BAR; PG8_WAIT_L(0); PG8_MMA(0, 1, At, B1); PG8_BAR;
            PG8_LDA(At, 0, 1); PG8_STAGE(PG8_SA(0, 0), a2, voffA);
            PG8_BAR; PG8_WAIT_L(0); PG8_MMA(1, 0, At, B0); PG8_BAR; PG8_SCHED;
            PG8_STAGE(PG8_SB(0, 1), b2 + hstep, voffB);
            PG8_WAIT_V(6); PG8_BAR; PG8_MMA(1, 1, At, B1); PG8_BAR;
            PG8_LDB(B0, 1, 0); PG8_SCHED; PG8_LDA(At, 1, 0); PG8_STAGE(PG8_SA(0, 1), a2 + hstep, voffA);
            PG8_WAIT_L(8); PG8_BAR; PG8_WAIT_L(0); PG8_MMA(0, 0, At, B0); PG8_BAR; PG8_SCHED;
            PG8_LDB(B1, 1, 1); PG8_STAGE(PG8_SB(1, 0), b3, voffB);
            PG8_BAR; PG8_WAIT_L(0); PG8_MMA(0, 1, At, B1); PG8_BAR;
            PG8_LDA(At, 1, 1); PG8_STAGE(PG8_SA(1, 0), a3, voffA);
            PG8_BAR; PG8_WAIT_L(0); PG8_MMA(1, 0, At, B0); PG8_BAR; PG8_SCHED;
            PG8_STAGE(PG8_SB(1, 1), b3 + hstep, voffB);
            PG8_WAIT_V(6); PG8_BAR; PG8_MMA(1, 1, At, B1); PG8_BAR;
            }
        }
        if constexpr (ALIGN_EPI) { if (wr == 0) PG8_BAR; }
        if constexpr (!Epi::AFTER_DRAIN) { E(acc, cur, wr, wc, fr, fq); S.done(cur); }
        if (!has_next) break;
#pragma unroll
        for (int a = 0; a < 2; ++a)
#pragma unroll
            for (int b = 0; b < 2; ++b)
#pragma unroll
                for (int m = 0; m < 4; ++m)
#pragma unroll
                    for (int n = 0; n < 2; ++n) acc[a][b][m][n] = (f32x4){0.f, 0.f, 0.f, 0.f};
        cur = nxt; cA = nA; cB = nB; ++ui;
        if constexpr (ALIGN_EPI) { if (wr == 1) PG8_BAR; }
    }
    PG8_WAIT_V(0);
    if constexpr (!ALIGN_EPI) { if (wr == 0) PG8_BAR; }
    PG8_BAR;
    if constexpr (Epi::AFTER_DRAIN) { E.fused(acc, cur, wr, wc, fr, fq, lds, wid, lane); S.done(cur); }
#undef PG8_SA
#undef PG8_SB
#undef PG8_STAGE
#undef PG8_LDA
#undef PG8_LDB
#undef PG8_MMA
#undef PG8_WAIT_V
#undef PG8_WAIT_L
#undef PG8_BAR
#undef PG8_SCHED
}
}
#define LAS __attribute__((address_space(3)))
using pg8::bf16_t; using pg8::cvt_pk_bf16; using pg8::bf2f; using pg8::bflo; using pg8::bfhi; using pg8::fsigmoid; using pg8::fsilu; using pg8::RMS_EPS;
typedef short bf16x8 __attribute__((ext_vector_type(8)));
typedef short s16x4 __attribute__((ext_vector_type(4)));
typedef float f32x4 __attribute__((ext_vector_type(4)));
typedef float f32x16 __attribute__((ext_vector_type(16)));
typedef unsigned u32x4 __attribute__((ext_vector_type(4)));
typedef unsigned u32x2 __attribute__((ext_vector_type(2)));
#define MFMA32(a, b, c) __builtin_amdgcn_mfma_f32_32x32x16_bf16((a), (b), (c), 0, 0, 0)
#define MFMA16(a, b, c) __builtin_amdgcn_mfma_f32_16x16x32_bf16((a), (b), (c), 0, 0, 0)
#define DI __device__ __forceinline__
DI int crow(int reg, int h) { return (reg & 3) + 8 * (reg >> 2) + 4 * h; }
DI unsigned short f2bf(float f) { unsigned u = __float_as_uint(f); return (unsigned short)((u + 0x7fffu + ((u >> 16) & 1u)) >> 16); }
DI unsigned pk2(float lo, float hi) { return (unsigned)f2bf(lo) | ((unsigned)f2bf(hi) << 16); }
#define LDS_WAIT() asm volatile("s_waitcnt lgkmcnt(0)" ::: "memory")

#define RLX_AGENT __ATOMIC_RELAXED, __HIP_MEMORY_SCOPE_AGENT
#define XB_TMO      128
#define XB_XCNT(j)  (256  + 64 * (j))
#define XB_XSUB(j)  (1280 + 64 * (j))
#define XB_XGEN(j)  (2304 + 64 * (j))
#define XB_TOP      3328
#define XB_TOPGEN   3392
#define XCD_BAR_WORDS 3456
#define XB_SPIN_CAP (1u << 18)

__device__ __forceinline__ unsigned xb_ld(unsigned* p)              { return __hip_atomic_load(p, __ATOMIC_RELAXED, __HIP_MEMORY_SCOPE_AGENT); }
__device__ __forceinline__ unsigned xb_add(unsigned* p, unsigned v) { return __hip_atomic_fetch_add(p, v, __ATOMIC_RELAXED, __HIP_MEMORY_SCOPE_AGENT); }
__device__ __forceinline__ unsigned xb_xcc_id() { return (unsigned)__builtin_amdgcn_s_getreg((3 << 11) | 20) & 0xFu; }
#define XB_SPIN(cond, bar) do { unsigned _sp = 0; while (cond) { __builtin_amdgcn_s_sleep(1); \
    if ((++_sp & 255u) == 0u) { if (xb_ld(&(bar)[XB_TMO])) break; if (_sp > XB_SPIN_CAP) { atomicAdd(&(bar)[XB_TMO], 1u); break; } } } } while (0)

struct XcdBarrier {
    unsigned* bar; unsigned x;
    volatile LAS unsigned* st;
};

__device__ __forceinline__ XcdBarrier xcd_barrier_post(unsigned* bar, volatile LAS unsigned* st) {
    XcdBarrier b; b.bar = bar; b.x = xb_xcc_id(); b.st = st;
    if (threadIdx.x == 0) (void)xb_add(&bar[XB_XCNT(b.x)], 1u);
    return b;
}
__device__ __forceinline__ void xcd_barrier_complete(unsigned* bar, unsigned x, unsigned& nloc, unsigned& nx) {
    const unsigned G = gridDim.x * gridDim.y * gridDim.z;
    unsigned sum, cnt, mine, sp = 0u;
    for (;;) {
        sum = 0u; cnt = 0u; mine = 0u;
#pragma unroll
        for (unsigned j = 0; j < 16; ++j) { const unsigned c = xb_ld(&bar[XB_XCNT(j)]); sum += c; cnt += (c > 0u) ? 1u : 0u; mine = (j == x) ? c : mine; }
        if (sum == G) break;
        __builtin_amdgcn_s_sleep(1);
        if ((++sp & 255u) == 0u) { if (xb_ld(&bar[XB_TMO])) break; if (sp > XB_SPIN_CAP) { atomicAdd(&bar[XB_TMO], 1u); break; } }
    }
    nloc = mine > 0u ? mine : 1u; nx = cnt > 0u ? cnt : 1u;
}

__device__ __forceinline__ void xcd_barrier(const XcdBarrier& b) {
    asm volatile("s_waitcnt vmcnt(0)" ::: "memory");
    __syncthreads();
    if (threadIdx.x == 0) {
        unsigned* bar = b.bar;
        __builtin_amdgcn_s_waitcnt(0);
        unsigned nloc = b.st[0], nx = b.st[1];
        if (nloc == 0u) { xcd_barrier_complete(bar, b.x, nloc, nx); b.st[0] = nloc; b.st[1] = nx; }
        const unsigned old = xb_add(&bar[XB_XSUB(b.x)], 1u);
        const unsigned gen = old / nloc;
        if (old + 1u == (gen + 1u) * nloc) {
            __builtin_amdgcn_fence(__ATOMIC_RELEASE, "agent");
            asm volatile("s_waitcnt vmcnt(0)" ::: "memory");
            const unsigned og = xb_add(&bar[XB_TOP], 1u);
            const unsigned tg = og / nx;
            if (og + 1u == (tg + 1u) * nx) xb_add(&bar[XB_TOPGEN], 1u);
            else XB_SPIN(xb_ld(&bar[XB_TOPGEN]) == tg, bar);
            __builtin_amdgcn_fence(__ATOMIC_ACQUIRE, "agent");
            xb_add(&bar[XB_XGEN(b.x)], 1u);
            asm volatile("s_waitcnt vmcnt(0)" ::: "memory");
        } else {
            XB_SPIN(xb_ld(&bar[XB_XGEN(b.x)]) == gen, bar);
            __builtin_amdgcn_fence(__ATOMIC_ACQUIRE, "agent");
            asm volatile("s_waitcnt vmcnt(0)" ::: "memory");
        }
    }
    __syncthreads();
}

constexpr int NWAVES = 8, NTHR = 512;
constexpr int BATCH = 2, T = 8192, D = 1024, M = BATCH * T, NMEM = 256, DFF = 2816;
constexpr size_t MiB = 1u << 20;
constexpr size_t WS_BAR = 212992;
constexpr size_t WS_ROWSS1 = 0, WS_ROWSS2 = 65536, WS_ROWSS3 = 131072, CTL_ZERO_BYTES = 262144;
constexpr size_t WS_MEMN = 1 * MiB, WS_MK = 2 * MiB, WS_MVT = 3 * MiB;
constexpr size_t WS_WMAIN = 4 * MiB, WS_WSWAP = 13 * MiB, WS_WA = 15 * MiB, WS_WB = 16 * MiB, WS_WOUT = 17 * MiB, WS_WXQ = 19 * MiB, WS_WXK = 21 * MiB, WS_WXV = 23 * MiB,
                 WS_WXO = 25 * MiB, WS_WFI = 27 * MiB, WS_WFO = 38 * MiB;
constexpr size_t WS_QA = 44 * MiB, WS_GA = 60 * MiB, WS_LF = 76 * MiB, WS_VT = 108 * MiB, WS_GATE = 140 * MiB, WS_U = 204 * MiB, WS_YA = 236 * MiB, WS_GAM = 252 * MiB;
constexpr size_t WS_T1 = 44 * MiB, WS_MERGED = 76 * MiB, WS_X1B = 108 * MiB, WS_XQ = 44 * MiB, WS_XO = 76 * MiB, WS_X2B = 108 * MiB, WS_FFH = 140 * MiB;
constexpr size_t WS_END = 256 * MiB;
constexpr size_t DO_H1 = 0, DO_QB = 32 * MiB, DO_KB = 48 * MiB, DO_YB = 0;
constexpr int LDS_BYTES = 147456;

DI float wave_sum(float v) {
#pragma unroll
    for (int o = 1; o < 64; o <<= 1) v += __shfl_xor(v, o);
    return v;
}
DI void p0_transpose_item(const float* W, int K, int N, bf16_t* dst, const float* gk, LAS float* scr, int k0, int n0, int lane) {
#pragma unroll 8
    for (int i = 0; i < 32; ++i) { const int kk = 2 * i + (lane >> 5); float w = W[(size_t)(k0 + kk) * N + n0 + (lane & 31)]; if (gk) w *= gk[k0 + kk]; scr[kk * 33 + (lane & 31)] = w; }
    LDS_WAIT();
    const int c = lane & 7;
#pragma unroll
    for (int j = 0; j < 4; ++j) { const int n = (lane >> 3) + 8 * j; const LAS float* s = scr + (8 * c) * 33 + n;
        u32x4 o; o.x = pk2(s[0 * 33], s[1 * 33]); o.y = pk2(s[2 * 33], s[3 * 33]); o.z = pk2(s[4 * 33], s[5 * 33]); o.w = pk2(s[6 * 33], s[7 * 33]);
        *(u32x4*)(dst + (size_t)n * K + k0 + 8 * c) = o; }
    LDS_WAIT();
}
DI void rms_row_to_bf16(const float* xrow, const float* g, bf16_t* orow, int lane) {
    const f32x4* xr = (const f32x4*)xrow + lane; const f32x4* gr = (const f32x4*)g + lane;
    f32x4 v[4]; float s = 0.f;
#pragma unroll
    for (int j = 0; j < 4; ++j) { v[j] = xr[64 * j]; s += (v[j].x * v[j].x + v[j].y * v[j].y) + (v[j].z * v[j].z + v[j].w * v[j].w); }
    const float rstd = rsqrtf(wave_sum(s) * (1.f / 1024.f) + RMS_EPS);
    unsigned long long* o8 = (unsigned long long*)orow + lane;
#pragma unroll
    for (int j = 0; j < 4; ++j) { const f32x4 gg = gr[64 * j];
        o8[64 * j] = (unsigned long long)pk2(v[j].x * rstd * gg.x, v[j].y * rstd * gg.y) | ((unsigned long long)pk2(v[j].z * rstd * gg.z, v[j].w * rstd * gg.w) << 32); }
}

DI void hgrn_a_item(LAS unsigned char* lds, int item, const float* LF, const bf16_t* VT, bf16_t* U, float* GAM) {
    const int tid = threadIdx.x, lane = tid & 63, wave = tid >> 6;
    const int bh = item >> 7, c = item & 127, b = bh >> 2, h = bh & 3;
    const size_t row0 = (size_t)b * T + c * 64;
    LAS float* PT = (LAS float*)(lds + 32768);
    LAS bf16_t* KT = (LAS bf16_t*)(lds + 34816);
    const int d = tid & 127, part = tid >> 7;
    float lf[16], bb[16];
#pragma unroll
    for (int j = 0; j < 16; ++j) lf[j] = LF[(row0 + part * 16 + j) * 512 + h * 128 + d];
    float run = 0.f;
#pragma unroll
    for (int j = 0; j < 16; ++j) { run += lf[j]; bb[j] = run; }
    PT[part * 128 + d] = run;
    __syncthreads();
    float off = 0.f, tot = 0.f;
#pragma unroll
    for (int p = 0; p < 4; ++p) { const float v = PT[p * 128 + d]; if (p < part) off += v; tot += v; }
    unsigned pk[8];
#pragma unroll
    for (int j = 0; j < 16; j += 2) { const float k0 = (1.f - __expf(lf[j])) * __expf(tot - (bb[j] + off)), k1 = (1.f - __expf(lf[j + 1])) * __expf(tot - (bb[j + 1] + off)); pk[j >> 1] = cvt_pk_bf16(k0, k1); }
    LAS u32x4* dst = (LAS u32x4*)(KT + d * 72 + part * 16);
    dst[0] = (u32x4){pk[0], pk[1], pk[2], pk[3]}; dst[1] = (u32x4){pk[4], pk[5], pk[6], pk[7]};
    if (part == 0) GAM[(size_t)item * 128 + d] = __expf(tot);
    __syncthreads();
    const int r = lane & 31, hh = lane >> 5, mt = wave >> 1, ntb = (wave & 1) * 2;
    f32x16 acc0, acc1;
#pragma unroll
    for (int i = 0; i < 16; ++i) { acc0[i] = 0.f; acc1[i] = 0.f; }
    const bf16_t* vrow = VT + (size_t)(h * 128 + mt * 32 + r) * M + row0 + 8 * hh;
#pragma unroll
    for (int s = 0; s < 4; ++s) { const bf16x8 a = *(const bf16x8*)(vrow + 16 * s);
        const bf16x8 b0 = *(const LAS bf16x8*)(KT + (ntb * 32 + r) * 72 + 16 * s + 8 * hh), b1 = *(const LAS bf16x8*)(KT + ((ntb + 1) * 32 + r) * 72 + 16 * s + 8 * hh);
        acc0 = MFMA32(a, b0, acc0); acc1 = MFMA32(a, b1, acc1); }
    bf16_t* up = U + (size_t)item * 16384;
#pragma unroll
    for (int i = 0; i < 16; ++i) { const int v = mt * 32 + crow(i, hh); up[v * 128 + ntb * 32 + r] = f2bf(acc0[i]); up[v * 128 + (ntb + 1) * 32 + r] = f2bf(acc1[i]); }
    __syncthreads();
}
DI void hgrn_scan(bf16_t* U, bf16_t* SD, const float* GAM, int G) {
    const int tid = threadIdx.x;
    if (tid >= 256) return;
    for (int e = blockIdx.x * 256 + tid; e < 65536; e += G * 256) {
        const int bh = e >> 13, rem = e & 8191;
        float s0 = 0.f, s1 = 0.f;
        unsigned* up = (unsigned*)(U + (size_t)bh * 128 * 16384) + rem; unsigned* sp = (unsigned*)(SD + (size_t)bh * 128 * 16384) + rem;
        const float* gp = GAM + (size_t)bh * 128 * 128 + ((rem * 2) & 127);
        for (int c0 = 0; c0 < 128; c0 += 8) {
            unsigned uu[8]; float g0[8], g1[8];
#pragma unroll
            for (int j = 0; j < 8; ++j) { uu[j] = up[(size_t)(c0 + j) * 8192]; g0[j] = gp[(c0 + j) * 128]; g1[j] = gp[(c0 + j) * 128 + 1]; }
#pragma unroll
            for (int j = 0; j < 8; ++j) { sp[(size_t)(c0 + j) * 8192] = pk2(s0, s1); s0 = g0[j] * s0 + bflo(uu[j]); s1 = g1[j] * s1 + bfhi(uu[j]); }
        }
    }
}
DI void hgrn_e_item(LAS unsigned char* lds, int item, const float* LF, const bf16_t* QA, const bf16_t* GA, const bf16_t* VT, const bf16_t* SST, const float* g_hgrn, bf16_t* YA) {
    const int tid = threadIdx.x, lane = tid & 63, wave = tid >> 6;
    const int bh = item >> 7, c = item & 127, b = bh >> 2, h = bh & 3;
    const size_t row0 = (size_t)b * T + c * 64;
    LAS float* PT = (LAS float*)(lds + 32768);
    LAS bf16_t* QT = (LAS bf16_t*)(lds + 34816);
    LAS bf16_t* QD = (LAS bf16_t*)(lds + 52224);
    LAS bf16_t* KD = (LAS bf16_t*)(lds + 69632);
    LAS bf16_t* SC = (LAS bf16_t*)(lds + 113152);
    LAS float* SSQ = (LAS float*)(lds + 122368);
    const int d = tid & 127, part = tid >> 7;
    float lf[16], bb[16];
#pragma unroll
    for (int j = 0; j < 16; ++j) lf[j] = LF[(row0 + part * 16 + j) * 512 + h * 128 + d];
    float run = 0.f;
#pragma unroll
    for (int j = 0; j < 16; ++j) { run += lf[j]; bb[j] = run; }
    PT[part * 128 + d] = run;
    for (int u = tid; u < 2304; u += NTHR) ((LAS unsigned*)SC)[u] = 0u;
    __syncthreads();
    const float B1 = PT[d], B2 = B1 + PT[128 + d], B3 = B2 + PT[256 + d];
    const float off = part == 0 ? 0.f : (part == 1 ? B1 : (part == 2 ? B2 : B3));
#pragma unroll
    for (int j = 0; j < 16; ++j) {
        const int t = part * 16 + j; const float bt = bb[j] + off;
        const float q = bf2f(QA[(row0 + t) * 512 + h * 128 + d]);
        QT[t * 136 + d] = f2bf(q * __expf(bt)); QD[t * 136 + d] = f2bf(q * __expf(bb[j]));
        const float k = 1.f - __expf(lf[j]);
#pragma unroll
        for (int ip = 0; ip < 4; ++ip) if (ip >= part) { const float beta = ip == 0 ? 0.f : (ip == 1 ? B1 : (ip == 2 ? B2 : B3));
            KD[(8 * ip * (ip + 1) + t) * 136 + d] = f2bf(k * __expf(beta - bt)); }
    }
    __syncthreads();
    for (int tile = wave; tile < 10; tile += 8) {
        const int i = tile >= 6 ? 3 : (tile >= 3 ? 2 : (tile >= 1 ? 1 : 0)), j = tile - (i * (i + 1)) / 2, base = 8 * i * (i + 1);
        const int r16 = lane & 15, q4 = lane >> 4;
        f32x4 sc = {0.f, 0.f, 0.f, 0.f};
#pragma unroll
        for (int s = 0; s < 4; ++s) { const bf16x8 a = *(const LAS bf16x8*)(QD + (16 * i + r16) * 136 + 32 * s + 8 * q4), bq = *(const LAS bf16x8*)(KD + (base + 16 * j + r16) * 136 + 32 * s + 8 * q4);
            sc = MFMA16(a, bq, sc); }
#pragma unroll
        for (int jj = 0; jj < 4; ++jj) { const int tl = 4 * q4 + jj; const bool ok = (j < i) || (r16 <= tl); SC[(16 * i + tl) * 72 + 16 * j + r16] = ok ? f2bf(sc[jj]) : (unsigned short)0; }
    }
    __syncthreads();
    const int mt = wave >> 2, nt = wave & 3, r = lane & 31, hh = lane >> 5;
    f32x16 o;
#pragma unroll
    for (int i = 0; i < 16; ++i) o[i] = 0.f;
    const bf16_t* sst = SST + (size_t)item * 16384 + (32 * nt + r) * 128 + 8 * hh;
#pragma unroll
    for (int s = 0; s < 8; ++s) { const bf16x8 a = *(const LAS bf16x8*)(QT + (32 * mt + r) * 136 + 16 * s + 8 * hh); const bf16x8 bs = *(const bf16x8*)(sst + 16 * s); o = MFMA32(a, bs, o); }
    const bf16_t* vt = VT + (size_t)(h * 128 + 32 * nt + r) * M + row0 + 8 * hh;
#pragma unroll
    for (int s = 0; s < 4; ++s) { const bf16x8 a = *(const LAS bf16x8*)(SC + (32 * mt + r) * 72 + 16 * s + 8 * hh); const bf16x8 bv = *(const bf16x8*)(vt + 16 * s); o = MFMA32(a, bv, o); }
#pragma unroll
    for (int i = 0; i < 16; ++i) { float s = o[i] * o[i];
        s += __shfl_xor(s, 1); s += __shfl_xor(s, 2); s += __shfl_xor(s, 4); s += __shfl_xor(s, 8); s += __shfl_xor(s, 16);
        if (r == 0) SSQ[(32 * mt + crow(i, hh)) * 4 + nt] = s; }
    __syncthreads();
    const int v = 32 * nt + r; const float gh = g_hgrn[h * 128 + v];
#pragma unroll
    for (int i = 0; i < 16; ++i) { const int t = 32 * mt + crow(i, hh);
        const float ss = (SSQ[t * 4] + SSQ[t * 4 + 1]) + (SSQ[t * 4 + 2] + SSQ[t * 4 + 3]); const float rstd = rsqrtf(ss * (1.f / 128.f) + RMS_EPS);
        const size_t off2 = (row0 + t) * 512 + h * 128 + v;
        YA[off2] = f2bf(o[i] * rstd * gh * bf2f(GA[off2])); }
    __syncthreads();
}
DI void sb_wave_item(LAS unsigned char* wl, int wi, const bf16_t* QB, const bf16_t* KB, const bf16_t* VT, bf16_t* YB) {
    const int lane = threadIdx.x & 63, r = lane & 31, hh = lane >> 5;
    const int b = wi >> 11, h = (wi >> 8) & 7, qb = wi & 255, t0 = qb * 32;
    const size_t rowb = (size_t)b * T;
    bf16x8 qf[4];
    { const bf16_t* qp = QB + (rowb + t0 + r) * 512 + h * 64 + 8 * hh;
#pragma unroll
      for (int s = 0; s < 4; ++s) qf[s] = *(const bf16x8*)(qp + 16 * s); }
    f32x16 o0, o1;
#pragma unroll
    for (int i = 0; i < 16; ++i) { o0[i] = 0.f; o1[i] = 0.f; }
    float carry = 0.f;
    const bf16_t* vt0 = VT + (size_t)(512 + h * 64 + r) * M + rowb + 4 * hh; const bf16_t* vt1 = vt0 + (size_t)32 * M;
    for (int kt = qb; kt >= 0; --kt) {
        const int key0 = kt * 32;
        const bf16_t* kp = KB + (rowb + key0 + r) * 512 + h * 64 + 8 * hh;
        f32x16 z;
#pragma unroll
        for (int i = 0; i < 16; ++i) z[i] = 0.f;
#pragma unroll
        for (int s = 0; s < 4; ++s) z = MFMA32(*(const bf16x8*)(kp + 16 * s), qf[s], z);
        s16x4 va0[2][2], va1[2][2];
#pragma unroll
        for (int s = 0; s < 2; ++s)
#pragma unroll
            for (int hf = 0; hf < 2; ++hf) { va0[s][hf] = *(const s16x4*)(vt0 + key0 + 16 * s + 8 * hf); va1[s][hf] = *(const s16x4*)(vt1 + key0 + 16 * s + 8 * hf); }
        const bool diag = (kt == qb);
        float sp[16];
#pragma unroll
        for (int i = 0; i < 16; ++i) { const float zi = z[i]; const bool valid = !diag || (crow(i, hh) < r);
            const float spv = fmaxf(zi, 0.f) + __logf(1.f + __expf(-fabsf(zi))); sp[i] = valid ? spv : 0.f; }
        float Gs[4], PG[4];
#pragma unroll
        for (int g = 0; g < 4; ++g) { Gs[g] = (sp[4 * g] + sp[4 * g + 1]) + (sp[4 * g + 2] + sp[4 * g + 3]); PG[g] = __shfl_xor(Gs[g], 32); }
        float R[4]; R[3] = 0.f; R[2] = Gs[3] + PG[3]; R[1] = R[2] + (Gs[2] + PG[2]); R[0] = R[1] + (Gs[1] + PG[1]);
        const float tot = R[0] + (Gs[0] + PG[0]);
        float av[16];
#pragma unroll
        for (int g = 0; g < 4; ++g) { const float after = carry + R[g] + (hh == 0 ? PG[g] : 0.f);
            float ins = 0.f;
#pragma unroll
            for (int e = 3; e >= 0; --e) { const int i = 4 * g + e; ins += sp[i]; const bool valid = !diag || (crow(i, hh) < r);
                av[i] = valid ? __expf(z[i] - (after + ins)) : 0.f; } }
        carry += tot;
        u32x4 p0, p1;
        p0.x = cvt_pk_bf16(av[0], av[1]); p0.y = cvt_pk_bf16(av[2], av[3]); p0.z = cvt_pk_bf16(av[4], av[5]); p0.w = cvt_pk_bf16(av[6], av[7]);
        p1.x = cvt_pk_bf16(av[8], av[9]); p1.y = cvt_pk_bf16(av[10], av[11]); p1.z = cvt_pk_bf16(av[12], av[13]); p1.w = cvt_pk_bf16(av[14], av[15]);
        const bf16x8 pb0 = __builtin_bit_cast(bf16x8, p0), pb1 = __builtin_bit_cast(bf16x8, p1);
        o0 = MFMA32(__builtin_shufflevector(va0[0][0], va0[0][1], 0, 1, 2, 3, 4, 5, 6, 7), pb0, o0);
        o0 = MFMA32(__builtin_shufflevector(va0[1][0], va0[1][1], 0, 1, 2, 3, 4, 5, 6, 7), pb1, o0);
        o1 = MFMA32(__builtin_shufflevector(va1[0][0], va1[0][1], 0, 1, 2, 3, 4, 5, 6, 7), pb0, o1);
        o1 = MFMA32(__builtin_shufflevector(va1[1][0], va1[1][1], 0, 1, 2, 3, 4, 5, 6, 7), pb1, o1);
        if (__all(carry > 104.f)) break;
    }
    LAS bf16_t* OL = (LAS bf16_t*)wl;
#pragma unroll
    for (int i = 0; i < 16; ++i) { OL[r * 72 + crow(i, hh)] = f2bf(o0[i]); OL[r * 72 + 32 + crow(i, hh)] = f2bf(o1[i]); }
    LDS_WAIT();
    { const int row = lane >> 1, half = lane & 1; bf16_t* gp = YB + (rowb + t0 + row) * 512 + h * 64 + half * 32;
#pragma unroll
      for (int k = 0; k < 4; ++k) *(u32x4*)(gp + 8 * k) = *(const LAS u32x4*)(OL + row * 72 + half * 32 + 8 * k); }
    LDS_WAIT();
}
DI void xattn_item(LAS unsigned char* lds, int item, const bf16_t* XQ, const bf16_t* MK, const bf16_t* MVT, bf16_t* XO) {
    const int tid = threadIdx.x, lane = tid & 63, wave = tid >> 6, r = lane & 31, hh = lane >> 5;
    const int b = item >> 7, h = (item >> 5) & 3, tile = item & 31;
    const size_t rowq = (size_t)b * T + tile * 256 + wave * 32;
    bf16x8 qf[16];
    { const bf16_t* qp = XQ + (rowq + r) * 1024 + h * 256 + 8 * hh;
#pragma unroll
      for (int s = 0; s < 16; ++s) qf[s] = *(const bf16x8*)(qp + 16 * s); }
    f32x16 S[8];
#pragma unroll
    for (int mt = 0; mt < 8; ++mt) {
#pragma unroll
        for (int i = 0; i < 16; ++i) S[mt][i] = 0.f;
        const bf16_t* kp = MK + (size_t)(b * NMEM + 32 * mt + r) * 1024 + h * 256 + 8 * hh;
#pragma unroll
        for (int s = 0; s < 16; ++s) S[mt] = MFMA32(*(const bf16x8*)(kp + 16 * s), qf[s], S[mt]);
    }
    float mx = -3.0e38f;
#pragma unroll
    for (int mt = 0; mt < 8; ++mt)
#pragma unroll
        for (int i = 0; i < 16; ++i) mx = fmaxf(mx, S[mt][i]);
    mx = fmaxf(mx, __shfl_xor(mx, 32));
    float sum = 0.f;
    bf16x8 P[8][2];
#pragma unroll
    for (int mt = 0; mt < 8; ++mt) {
        float p[16];
#pragma unroll
        for (int i = 0; i < 16; ++i) { p[i] = __expf(S[mt][i] - mx); sum += p[i]; }
        u32x4 p0, p1;
        p0.x = cvt_pk_bf16(p[0], p[1]); p0.y = cvt_pk_bf16(p[2], p[3]); p0.z = cvt_pk_bf16(p[4], p[5]); p0.w = cvt_pk_bf16(p[6], p[7]);
        p1.x = cvt_pk_bf16(p[8], p[9]); p1.y = cvt_pk_bf16(p[10], p[11]); p1.z = cvt_pk_bf16(p[12], p[13]); p1.w = cvt_pk_bf16(p[14], p[15]);
        P[mt][0] = __builtin_bit_cast(bf16x8, p0); P[mt][1] = __builtin_bit_cast(bf16x8, p1);
    }
    sum += __shfl_xor(sum, 32);
    const float inv = 1.f / sum;
    LAS bf16_t* OL = (LAS bf16_t*)(lds + wave * 16896);
#pragma unroll
    for (int dt = 0; dt < 8; ++dt) {
        f32x16 O;
#pragma unroll
        for (int i = 0; i < 16; ++i) O[i] = 0.f;
        const bf16_t* vp = MVT + (size_t)(h * 256 + 32 * dt + r) * 512 + b * NMEM + 4 * hh;
#pragma unroll
        for (int mt = 0; mt < 8; ++mt)
#pragma unroll
            for (int s = 0; s < 2; ++s) { const s16x4 lo = *(const s16x4*)(vp + 32 * mt + 16 * s), hi = *(const s16x4*)(vp + 32 * mt + 16 * s + 8);
                O = MFMA32(__builtin_shufflevector(lo, hi, 0, 1, 2, 3, 4, 5, 6, 7), P[mt][s], O); }
#pragma unroll
        for (int i = 0; i < 16; ++i) OL[r * 264 + 32 * dt + crow(i, hh)] = f2bf(O[i] * inv);
    }
    LDS_WAIT();
#pragma unroll
    for (int k = 0; k < 16; ++k) { const int chunk = k * 64 + lane, row = chunk >> 5, c16 = chunk & 31;
        *(u32x4*)(XO + (rowq + row) * 1024 + h * 256 + c16 * 8) = *(const LAS u32x4*)(OL + row * 264 + c16 * 8); }
    LDS_WAIT();
}

constexpr int NPHASE = 13;
struct Args { const float* in[19]; float* out; unsigned char* ws; int ph_lo, ph_hi, probe, pad; };
#ifndef MK_ONE_LAUNCH
#define MK_ONE_LAUNCH 1
#endif

__global__ void __launch_bounds__(NTHR, 2) fwd_kernel(Args args) {
    extern __shared__ __attribute__((aligned(16))) unsigned char lds_raw[];
    LAS unsigned char* lds = (LAS unsigned char*)lds_raw;
    const int tid = threadIdx.x, lane = tid & 63, wave = __builtin_amdgcn_readfirstlane(tid >> 6);
    const int G = gridDim.x, bx = blockIdx.x;
    unsigned char* ws = args.ws; unsigned char* dob = (unsigned char*)args.out;
    const float* x = args.in[0]; const float* mem = args.in[1]; const float* g_mix = args.in[2]; const float* w_in = args.in[3]; const float* lb_table = args.in[4];
    const float* g_hgrn = args.in[5]; const float* w_gate = args.in[6]; const float* w_pa = args.in[7]; const float* w_pb = args.in[8]; const float* w_out = args.in[9];
    const float* g_xattn = args.in[10]; const float* g_mem = args.in[11]; const float* w_xq = args.in[12]; const float* w_xkv = args.in[13]; const float* w_xo = args.in[14];
    const float* g_ffn = args.in[15]; const float* w_ffn_in = args.in[16]; const float* w_ffn_out = args.in[17]; const float* g_final = args.in[18];
    float* ROWSS1 = (float*)(ws + WS_ROWSS1); float* ROWSS2 = (float*)(ws + WS_ROWSS2); float* ROWSS3 = (float*)(ws + WS_ROWSS3);
    bf16_t* MEMN = (bf16_t*)(ws + WS_MEMN); bf16_t* MK = (bf16_t*)(ws + WS_MK); bf16_t* MVT = (bf16_t*)(ws + WS_MVT);
    bf16_t* WMAIN = (bf16_t*)(ws + WS_WMAIN); bf16_t* WSWAP = (bf16_t*)(ws + WS_WSWAP); bf16_t* WA = (bf16_t*)(ws + WS_WA); bf16_t* WB = (bf16_t*)(ws + WS_WB);
    bf16_t* WOUT = (bf16_t*)(ws + WS_WOUT); bf16_t* WXQ = (bf16_t*)(ws + WS_WXQ); bf16_t* WXK = (bf16_t*)(ws + WS_WXK); bf16_t* WXV = (bf16_t*)(ws + WS_WXV);
    bf16_t* WXO = (bf16_t*)(ws + WS_WXO); bf16_t* WFI = (bf16_t*)(ws + WS_WFI); bf16_t* WFO = (bf16_t*)(ws + WS_WFO);
    bf16_t* QA = (bf16_t*)(ws + WS_QA); bf16_t* GA = (bf16_t*)(ws + WS_GA); float* LF = (float*)(ws + WS_LF); bf16_t* VT = (bf16_t*)(ws + WS_VT);
    bf16_t* GATE = (bf16_t*)(ws + WS_GATE); bf16_t* U = (bf16_t*)(ws + WS_U); bf16_t* YA = (bf16_t*)(ws + WS_YA); float* GAM = (float*)(ws + WS_GAM);
    bf16_t* T1 = (bf16_t*)(ws + WS_T1); bf16_t* MERGED = (bf16_t*)(ws + WS_MERGED); bf16_t* X1B = (bf16_t*)(ws + WS_X1B); bf16_t* XQ = (bf16_t*)(ws + WS_XQ);
    bf16_t* XO = (bf16_t*)(ws + WS_XO); bf16_t* X2B = (bf16_t*)(ws + WS_X2B); bf16_t* FFH = (bf16_t*)(ws + WS_FFH);
    bf16_t* H1 = (bf16_t*)(dob + DO_H1); bf16_t* QB = (bf16_t*)(dob + DO_QB); bf16_t* KB = (bf16_t*)(dob + DO_KB); bf16_t* YB = (bf16_t*)(dob + DO_YB);
    float* XR = args.out;

    volatile LAS unsigned* MISC = (volatile LAS unsigned*)(lds + 147392);
    if (tid < 16) MISC[tid] = 0u;
    __syncthreads();
    XcdBarrier bar; bar.bar = (unsigned*)(ws + WS_BAR); bar.x = 0; bar.st = MISC;
    if (args.ph_hi - args.ph_lo > 1) bar = xcd_barrier_post((unsigned*)(ws + WS_BAR), MISC);
    if (args.probe == 0x7fffffff) cg::this_grid().sync();
    const int lo = args.ph_lo, hi = args.ph_hi; const bool pr = args.probe != 0;
    float* PRO = (float*)(ws + 140 * MiB); bf16_t* PRB = (bf16_t*)(ws + 204 * MiB); float* PRS = (float*)(ws + 196608);
#define IN(k) (lo <= (k) && (k) < hi)
#define SEAM(k) do { if (IN(k) && IN((k) + 1)) xcd_barrier(bar); } while (0)

    if (IN(0)) {
        LAS float* scr = (LAS float*)(lds + wave * 16384);
        const int gw = bx * NWAVES + wave, NGW = G * NWAVES;
        constexpr int I_IN = 16 * 112, I_GATE = 16 * 64, I_A = 8 * 32, I_B = 8 * 32, I_OUT = 16 * 32, I_XQ = 16 * 32, I_XKV = 16 * 64, I_XO = 16 * 32, I_FI = 16 * 176, I_FO = 44 * 32;
        constexpr int NITEMS = I_IN + I_GATE + I_A + I_B + I_OUT + I_XQ + I_XKV + I_XO + I_FI + I_FO;
        for (int it = gw; it < NITEMS; it += NGW) {
            int r = it;
            if (r < I_IN) { const int nblk = 112, k0 = 64 * (r / nblk), n0 = 32 * (r % nblk), seg = n0 >> 9;
                bf16_t* dst = (seg < 2) ? WMAIN + (size_t)n0 * 1024 : (seg == 2) ? WSWAP + (size_t)(n0 - 1024) * 1024 : (seg < 6) ? WMAIN + (size_t)(n0 - 512) * 1024 : WSWAP + (size_t)(n0 - 3072 + 512) * 1024;
                p0_transpose_item(w_in, 1024, 3584, dst, nullptr, scr, k0, n0, lane); continue; } r -= I_IN;
            if (r < I_GATE) { const int nblk = 64, k0 = 64 * (r / nblk), n0 = 32 * (r % nblk); p0_transpose_item(w_gate, 1024, 2048, WMAIN + (size_t)(2560 + n0) * 1024, nullptr, scr, k0, n0, lane); continue; } r -= I_GATE;
            if (r < I_A) { const int nblk = 32, k0 = 64 * (r / nblk), n0 = 32 * (r % nblk); p0_transpose_item(w_pa, 512, 1024, WA + (size_t)n0 * 512, nullptr, scr, k0, n0, lane); continue; } r -= I_A;
            if (r < I_B) { const int nblk = 32, k0 = 64 * (r / nblk), n0 = 32 * (r % nblk); p0_transpose_item(w_pb, 512, 1024, WB + (size_t)n0 * 512, nullptr, scr, k0, n0, lane); continue; } r -= I_B;
            if (r < I_OUT) { const int nblk = 32, k0 = 64 * (r / nblk), n0 = 32 * (r % nblk); p0_transpose_item(w_out, 1024, 1024, WOUT + (size_t)n0 * 1024, nullptr, scr, k0, n0, lane); continue; } r -= I_OUT;
            if (r < I_XQ) { const int nblk = 32, k0 = 64 * (r / nblk), n0 = 32 * (r % nblk); p0_transpose_item(w_xq, 1024, 1024, WXQ + (size_t)n0 * 1024, g_xattn, scr, k0, n0, lane); continue; } r -= I_XQ;
            if (r < I_XKV) { const int nblk = 64, k0 = 64 * (r / nblk), n0 = 32 * (r % nblk);
                bf16_t* dst = n0 < 1024 ? WXK + (size_t)n0 * 1024 : WXV + (size_t)(n0 - 1024) * 1024;
                p0_transpose_item(w_xkv, 1024, 2048, dst, nullptr, scr, k0, n0, lane); continue; } r -= I_XKV;
            if (r < I_XO) { const int nblk = 32, k0 = 64 * (r / nblk), n0 = 32 * (r % nblk); p0_transpose_item(w_xo, 1024, 1024, WXO + (size_t)n0 * 1024, nullptr, scr, k0, n0, lane); continue; } r -= I_XO;
            if (r < I_FI) { const int nblk = 176, k0 = 64 * (r / nblk), n0 = 32 * (r % nblk); const int up = n0 >= DFF, j = up ? n0 - DFF : n0;
                p0_transpose_item(w_ffn_in, 1024, 2 * DFF, WFI + (size_t)(256 * (j >> 7) + 128 * up + (j & 127)) * 1024, g_ffn, scr, k0, n0, lane); continue; } r -= I_FI;
            { const int nblk = 32, k0 = 64 * (r / nblk), n0 = 32 * (r % nblk); p0_transpose_item(w_ffn_out, DFF, 1024, WFO + (size_t)n0 * DFF, nullptr, scr, k0, n0, lane); }
        }
        for (int m = gw; m < M + BATCH * NMEM; m += NGW) {
            if (m < M) rms_row_to_bf16(x + (size_t)m * D, g_mix, H1 + (size_t)m * D, lane);
            else rms_row_to_bf16(mem + (size_t)(m - M) * D, g_mem, MEMN + (size_t)(m - M) * D, lane);
        }
        __syncthreads();
    }
    SEAM(0);
    if (IN(1)) {
        { pg8::Gemm g{H1, WMAIN, M, 4608, 1024}; pg8::StaticOrder S; S.init(M, 4608, G, bx);
          pg8::EpiMain E{QA, GA, QB, KB, GATE, LF, lb_table};
          pg8::gemm_phase<pg8::EpiMain, pg8::StaticOrder, true, true>(lds, g, S, E); }
        { pg8::Gemm g{WSWAP, H1, 1024, M, 1024}; pg8::StaticOrder S; S.init(1024, M, G, bx);
          pg8::EpiStore E{VT, M};
          pg8::gemm_phase<pg8::EpiStore, pg8::StaticOrder, true, true>(lds, g, S, E); }
        { pg8::Gemm g{MEMN, WXK, BATCH * NMEM, 1024, 1024}; pg8::StaticOrder S; S.init(BATCH * NMEM, 1024, G, (bx + G - (128 % G)) % G);
          pg8::EpiStore E{MK, 1024};
          pg8::gemm_phase<pg8::EpiStore, pg8::StaticOrder, true, true>(lds, g, S, E); }
        { pg8::Gemm g{WXV, MEMN, 1024, BATCH * NMEM, 1024}; pg8::StaticOrder S; S.init(1024, BATCH * NMEM, G, (bx + G - (136 % G)) % G);
          pg8::EpiStore E{MVT, BATCH * NMEM};
          pg8::gemm_phase<pg8::EpiStore, pg8::StaticOrder, true, true>(lds, g, S, E); }
    }
    SEAM(1);
    if (IN(2)) {
        for (int item = bx; item < 1024; item += G) hgrn_a_item(lds, item, LF, VT, U, GAM);
        for (int wi = bx * NWAVES + wave; wi < 4096; wi += G * NWAVES) sb_wave_item(lds + wave * 4608, wi, QB, KB, VT, YB);
    }
    SEAM(2);
    if (IN(3)) hgrn_scan(U, pr ? (bf16_t*)(dob + 32 * MiB) : U, GAM, G);
    SEAM(3);
    if (IN(4)) { for (int item = bx; item < 1024; item += G) hgrn_e_item(lds, item, LF, QA, GA, VT, U, g_hgrn, YA); }
    SEAM(4);
    if (IN(5)) {
        { pg8::Gemm g{YA, WA, M, 1024, 512}; pg8::StaticOrder S; S.init(M, 1024, G, bx);
          pg8::EpiGate E{GATE, nullptr, T1};
          pg8::gemm_phase<pg8::EpiGate, pg8::StaticOrder, true, true>(lds, g, S, E); }
        { pg8::Gemm g{YB, WB, M, 1024, 512}; pg8::StaticOrder S; S.init(M, 1024, G, bx);
          pg8::EpiGate E{GATE + 1024, T1, MERGED};
          pg8::gemm_phase<pg8::EpiGate, pg8::StaticOrder, true, true>(lds, g, S, E); }
    }
    SEAM(5);
    if (IN(6)) { pg8::Gemm g{MERGED, WOUT, M, 1024, 1024}; pg8::StaticOrder S; S.init(M, 1024, G, bx);
        pg8::EpiResid E{x, pr ? PRO : XR, pr ? PRB : X1B, pr ? PRS : ROWSS1};
        pg8::gemm_phase<pg8::EpiResid, pg8::StaticOrder, true, true>(lds, g, S, E); }
    SEAM(6);
    if (IN(7)) { pg8::Gemm g{X1B, WXQ, M, 1024, 1024}; pg8::StaticOrder S; S.init(M, 1024, G, bx);
        pg8::EpiRowScale E{ROWSS1, XQ, 0.0625f};
        pg8::gemm_phase<pg8::EpiRowScale, pg8::StaticOrder, true, true>(lds, g, S, E); }
    SEAM(7);
    if (IN(8)) { for (int item = bx; item < 256; item += G) { xattn_item(lds, item, XQ, MK, MVT, XO); __syncthreads(); } }
    SEAM(8);
    if (IN(9)) { pg8::Gemm g{XO, WXO, M, 1024, 1024}; pg8::StaticOrder S; S.init(M, 1024, G, bx);
        pg8::EpiResid E{XR, pr ? PRO : XR, pr ? PRB : X2B, pr ? PRS : ROWSS2};
        pg8::gemm_phase<pg8::EpiResid, pg8::StaticOrder, true, true>(lds, g, S, E); }
    SEAM(9);
    if (IN(10)) { pg8::Gemm g{X2B, WFI, M, 2 * DFF, 1024}; pg8::StaticOrder S; S.init(M, 2 * DFF, G, bx);
        pg8::EpiSwiglu E{ROWSS2, FFH};
        pg8::gemm_phase<pg8::EpiSwiglu, pg8::StaticOrder, true, true>(lds, g, S, E); }
    SEAM(10);
    if (IN(11)) { pg8::Gemm g{FFH, WFO, M, 1024, DFF}; pg8::StaticOrder S; S.init(M, 1024, G, bx);
        pg8::EpiResid E{XR, pr ? (float*)(ws + 44 * MiB) : XR, nullptr, pr ? PRS : ROWSS3};
        pg8::gemm_phase<pg8::EpiResid, pg8::StaticOrder, true, true>(lds, g, S, E); }
    SEAM(11);
    if (IN(12)) {
        const int gw = bx * NWAVES + wave, NGW = G * NWAVES;
        for (int m = gw; m < M; m += NGW) {
            const float rstd = rsqrtf(ROWSS3[m] * (1.f / 1024.f) + RMS_EPS);
            f32x4* xr = (f32x4*)(XR + (size_t)m * D) + lane; const f32x4* gr = (const f32x4*)g_final + lane;
#pragma unroll
            for (int j = 0; j < 4; ++j) { f32x4 v = xr[64 * j]; const f32x4 gg = gr[64 * j]; v = v * rstd; v = v * gg; xr[64 * j] = v; }
        }
    }
#ifdef PROBE_SYNCS
    for (int i = 0; i < PROBE_SYNCS; ++i) cg::this_grid().sync();
#endif
#undef IN
#undef SEAM
}

extern "C" void kernel_launch(void* const* d_in, const int* in_sizes, int n_in, void* d_out, int out_size, void* d_ws, size_t ws_size, hipStream_t stream) {
    static int grid = 0;
    if (grid == 0) {
        if (n_in != 19 || out_size != M * D || ws_size < WS_END) { fprintf(stderr, "kernel_launch: unexpected shapes (n_in %d out %d ws %zu)\n", n_in, out_size, ws_size); grid = -1; return; }
        int dev = 0, cus = 0, per_cu = 0;
        hipGetDevice(&dev); hipDeviceGetAttribute(&cus, hipDeviceAttributeMultiprocessorCount, dev);
        hipFuncSetAttribute((const void*)fwd_kernel, hipFuncAttributeMaxDynamicSharedMemorySize, LDS_BYTES);
        hipOccupancyMaxActiveBlocksPerMultiprocessor(&per_cu, (const void*)fwd_kernel, NTHR, LDS_BYTES);
        if (per_cu < 1) { fprintf(stderr, "kernel_launch: occupancy query says %d blocks per CU\n", per_cu); per_cu = 1; }
        (void)hipGetLastError();
        grid = cus * per_cu;
        fprintf(stderr, "kernel_launch: grid %d (cus %d x %d)\n", grid, cus, per_cu);
    }
    if (grid < 0) return;
    hipMemsetAsync((char*)d_ws, 0, CTL_ZERO_BYTES, stream);
    Args a{};
    for (int i = 0; i < 19; ++i) a.in[i] = (const float*)d_in[i];
    a.out = (float*)d_out; a.ws = (unsigned char*)d_ws;
#if MK_ONE_LAUNCH
    a.ph_lo = 0; a.ph_hi = NPHASE;
    void* kargs[] = {&a};
    hipError_t e = hipLaunchCooperativeKernel((const void*)fwd_kernel, dim3(grid), dim3(NTHR), kargs, LDS_BYTES, stream);
    if (e != hipSuccess) fprintf(stderr, "cooperative launch failed: %s (grid %d)\n", hipGetErrorString(e), grid);
#else
    for (int p = 0; p < NPHASE; ++p) { a.ph_lo = p; a.ph_hi = p + 1; hipLaunchKernelGGL(fwd_kernel, dim3(grid), dim3(NTHR), LDS_BYTES, stream, a);
#ifdef PROBE_MASK
        if ((PROBE_MASK >> p) & 1) { a.probe = 1; for (int rr = 0; rr < PROBE_REP; ++rr) hipLaunchKernelGGL(fwd_kernel, dim3(grid), dim3(NTHR), LDS_BYTES, stream, a); a.probe = 0; }
#endif
    }
#endif
}
```

```cpp
#include <hip/hip_runtime.h>
#include <hip/hip_cooperative_groups.h>
#include <cstdio>
#include <cstdint>
namespace cg = cooperative_groups;
namespace pg8 {
#define PG8_LAS __attribute__((address_space(3)))
typedef unsigned short bf16_t;
typedef short bf16x8 __attribute__((ext_vector_type(8)));
typedef float f32x4 __attribute__((ext_vector_type(4)));
typedef unsigned u32x4 __attribute__((ext_vector_type(4)));
constexpr int BM = 256, BK = 64, HALF = 128, HTB = HALF * BK * 2  , STAGE_BYTES = 8 * HTB, NXCD = 8, WGM = 8;

__host__ __device__ __forceinline__ int lds_byte(int r, int c) { const int st = (r >> 4) * 2 + (c >> 5), rr = r & 15, cc = c & 31, ob = rr * 64 + cc * 2; return st * 1024 + (ob ^ (((ob >> 9) & 1) << 5)); }
__host__ __device__ __forceinline__ void stage_rc(int b, int& R, int& C) { const int st = b / 1024, sb = b % 1024, swz = sb ^ (((sb >> 9) & 1) << 5); R = (st >> 1) * 16 + swz / 64; C = (st & 1) * 32 + (swz % 64) / 2; }
__host__ __device__ __forceinline__ int perm32(int rho) { const int n = rho >> 4, i = rho & 15; return 8 * (i >> 2) + 4 * n + (i & 3); }

struct Unit { int pm, pn; };
struct Gemm { const bf16_t* A; const bf16_t* Bt; int M, N, K; };

struct StaticOrder {
    int nM, nN, nwg, G, c;
    __host__ __device__ void init(int M, int N, int G_, int c_) { nM = M / BM; nN = N / BM; nwg = nM * nN; G = G_; c = c_; }
    __host__ __device__ bool next(int i, Unit& u) const {
        const long L = (long)i * G + c; if (L >= nwg) return false;
        int wgid = (int)L; { const int q = nwg / NXCD, r = nwg % NXCD, xcd = wgid % NXCD, off = wgid / NXCD; wgid = (xcd < r ? xcd * (q + 1) : r * (q + 1) + (xcd - r) * q) + off; }
        const int nig = WGM * nN, gid = wgid / nig, fm = gid * WGM, gsz = (nM - fm) < WGM ? (nM - fm) : WGM;
        u.pm = fm + ((wgid % nig) % gsz); u.pn = (wgid % nig) / gsz; return true;
    }
    __device__ __forceinline__ void a_ready(const Unit&) const {}
    __device__ __forceinline__ void done(const Unit&) const {}
};
typedef unsigned u32x2 __attribute__((ext_vector_type(2)));

__device__ __forceinline__ unsigned cvt_pk_bf16(float lo, float hi) { unsigned r; asm volatile("v_cvt_pk_bf16_f32 %0, %1, %2" : "=v"(r) : "v"(lo), "v"(hi)); return r; }
__device__ __forceinline__ float bf2f(unsigned short b) { return __uint_as_float((unsigned)b << 16); }
__device__ __forceinline__ float bflo(unsigned w) { return __uint_as_float(w << 16); }
__device__ __forceinline__ float bfhi(unsigned w) { return __uint_as_float(w & 0xffff0000u); }
__device__ __forceinline__ float fsigmoid(float x) { return __builtin_amdgcn_rcpf(1.f + __expf(-x)); }
__device__ __forceinline__ float fsilu(float x) { return x * fsigmoid(x); }
constexpr float RMS_EPS = 1e-6f;

struct EpiMain {
    static constexpr bool PERM = true, AFTER_DRAIN = false;
    bf16_t *QA, *GA, *QB, *KB, *GATE; float* LF; const float* lbt;
    __device__ __forceinline__ void operator()(const f32x4 (&acc)[2][2][4][2], const Unit& u, int wr, int wc, int fr, int fq) const {
        const int pn = u.pn; const int row0 = u.pm * BM + wr * 64 + fr; const int cin = wc * 32 + 8 * fq;
        if (pn == 2 || pn == 3) {
#pragma unroll
            for (int bj = 0; bj < 2; ++bj) {
                const int col = (pn - 2) * 256 + bj * HALF + cin;
                float lb[8];
#pragma unroll
                for (int e = 0; e < 8; ++e) { const float t0 = lbt[col + e], t1 = lbt[512 + col + e]; lb[e] = 1.f / (1.f + __expf(t1 - t0)); }
#pragma unroll
                for (int ai = 0; ai < 2; ++ai)
#pragma unroll
                    for (int m = 0; m < 4; ++m) {
                        float* p = LF + (size_t)(row0 + ai * HALF + m * 16) * 512 + col;
                        const f32x4 v0 = acc[ai][bj][m][0], v1 = acc[ai][bj][m][1]; f32x4 o0, o1;
#pragma unroll
                        for (int e = 0; e < 4; ++e) { o0[e] = __logf(lb[e] + (1.f - lb[e]) * fsigmoid(v0[e])); o1[e] = __logf(lb[4 + e] + (1.f - lb[4 + e]) * fsigmoid(v1[e])); }
                        *(f32x4*)p = o0; *(f32x4*)(p + 4) = o1;
                    }
            }
            return;
        }
        int mode; bf16_t* O; int ldc, colt;
        if (pn < 2) { mode = 1; O = QA; ldc = 512; colt = pn * 256; }
        else if (pn < 6) { mode = 1; O = GA; ldc = 512; colt = (pn - 4) * 256; }
        else if (pn < 8) { mode = 2; O = QB; ldc = 512; colt = (pn - 6) * 256; }
        else if (pn < 10) { mode = 0; O = KB; ldc = 512; colt = (pn - 8) * 256; }
        else { mode = 3; O = GATE; ldc = 2048; colt = (pn - 10) * 256; }
#pragma unroll
        for (int ai = 0; ai < 2; ++ai)
#pragma unroll
            for (int m = 0; m < 4; ++m) { bf16_t* rowp = O + (size_t)(row0 + ai * HALF + m * 16) * ldc + colt + cin;
#pragma unroll
                for (int bj = 0; bj < 2; ++bj) { f32x4 v0 = acc[ai][bj][m][0], v1 = acc[ai][bj][m][1];
                    if (mode == 1) {
#pragma unroll
                        for (int e = 0; e < 4; ++e) { v0[e] = fsilu(v0[e]); v1[e] = fsilu(v1[e]); } }
                    else if (mode == 2) { v0 = v0 * 0.125f; v1 = v1 * 0.125f; }
                    else if (mode == 3) {
#pragma unroll
                        for (int e = 0; e < 4; ++e) { v0[e] = fsigmoid(v0[e]); v1[e] = fsigmoid(v1[e]); } }
                    u32x4 w; w.x = cvt_pk_bf16(v0[0], v0[1]); w.y = cvt_pk_bf16(v0[2], v0[3]); w.z = cvt_pk_bf16(v1[0], v1[1]); w.w = cvt_pk_bf16(v1[2], v1[3]);
                    *(u32x4*)(rowp + bj * HALF) = w; } }
    }
};
struct EpiStore {
    static constexpr bool PERM = true, AFTER_DRAIN = false;
    bf16_t* O; int ldc;
    __device__ __forceinline__ void operator()(const f32x4 (&acc)[2][2][4][2], const Unit& u, int wr, int wc, int fr, int fq) const {
        const int row0 = u.pm * BM + wr * 64 + fr; const int col0 = u.pn * BM + wc * 32 + 8 * fq;
#pragma unroll
        for (int ai = 0; ai < 2; ++ai)
#pragma unroll
            for (int m = 0; m < 4; ++m) { bf16_t* rowp = O + (size_t)(row0 + ai * HALF + m * 16) * ldc + col0;
#pragma unroll
                for (int bj = 0; bj < 2; ++bj) { const f32x4 v0 = acc[ai][bj][m][0], v1 = acc[ai][bj][m][1];
                    u32x4 w; w.x = cvt_pk_bf16(v0[0], v0[1]); w.y = cvt_pk_bf16(v0[2], v0[3]); w.z = cvt_pk_bf16(v1[0], v1[1]); w.w = cvt_pk_bf16(v1[2], v1[3]);
                    *(u32x4*)(rowp + bj * HALF) = w; } }
    }
};
struct EpiGate {
    static constexpr bool PERM = true, AFTER_DRAIN = false;
    const bf16_t* gate; const bf16_t* addin; bf16_t* out;
    __device__ __forceinline__ void operator()(const f32x4 (&acc)[2][2][4][2], const Unit& u, int wr, int wc, int fr, int fq) const {
        const int row0 = u.pm * BM + wr * 64 + fr; const int col0 = u.pn * BM + wc * 32 + 8 * fq;
#pragma unroll
        for (int ai = 0; ai < 2; ++ai)
#pragma unroll
            for (int m = 0; m < 4; ++m) { const size_t row = (size_t)(row0 + ai * HALF + m * 16);
#pragma unroll
                for (int bj = 0; bj < 2; ++bj) { const f32x4 v0 = acc[ai][bj][m][0], v1 = acc[ai][bj][m][1]; const int col = col0 + bj * HALF;
                    const u32x4 g = *(const u32x4*)(gate + row * 2048 + col);
                    float r[8] = { bflo(g.x) * v0[0], bfhi(g.x) * v0[1], bflo(g.y) * v0[2], bfhi(g.y) * v0[3], bflo(g.z) * v1[0], bfhi(g.z) * v1[1], bflo(g.w) * v1[2], bfhi(g.w) * v1[3] };
                    if (addin) { const u32x4 t = *(const u32x4*)(addin + row * 1024 + col);
                        r[0] += bflo(t.x); r[1] += bfhi(t.x); r[2] += bflo(t.y); r[3] += bfhi(t.y); r[4] += bflo(t.z); r[5] += bfhi(t.z); r[6] += bflo(t.w); r[7] += bfhi(t.w); }
                    u32x4 w; w.x = cvt_pk_bf16(r[0], r[1]); w.y = cvt_pk_bf16(r[2], r[3]); w.z = cvt_pk_bf16(r[4], r[5]); w.w = cvt_pk_bf16(r[6], r[7]);
                    *(u32x4*)(out + row * 1024 + col) = w; } }
    }
};
struct EpiResid {
    static constexpr bool PERM = false, AFTER_DRAIN = false;
    const float* base; float* out; bf16_t* xb; float* rowss;
    __device__ __forceinline__ void operator()(const f32x4 (&acc)[2][2][4][2], const Unit& u, int wr, int wc, int fr, int fq) const {
        const int row0 = u.pm * BM + wr * 64 + fr; const int col0 = u.pn * BM + wc * 32 + 4 * fq;
#pragma unroll
        for (int ai = 0; ai < 2; ++ai)
#pragma unroll
            for (int m = 0; m < 4; ++m) { const size_t row = (size_t)(row0 + ai * HALF + m * 16); float ss = 0.f;
#pragma unroll
                for (int bj = 0; bj < 2; ++bj)
#pragma unroll
                    for (int n = 0; n < 2; ++n) { const size_t off = row * 1024 + col0 + bj * HALF + n * 16;
                        const f32x4 v = *(const f32x4*)(base + off) + acc[ai][bj][m][n];
                        *(f32x4*)(out + off) = v; ss += (v[0] * v[0] + v[1] * v[1]) + (v[2] * v[2] + v[3] * v[3]);
                        if (xb) { u32x2 w; w.x = cvt_pk_bf16(v[0], v[1]); w.y = cvt_pk_bf16(v[2], v[3]); *(u32x2*)(xb + off) = w; } }
                ss += __shfl_xor(ss, 16); ss += __shfl_xor(ss, 32);
                if (fq == 0) unsafeAtomicAdd(rowss + row, ss); }
    }
};
struct EpiRowScale {
    static constexpr bool PERM = true, AFTER_DRAIN = false;
    const float* rowss; bf16_t* out; float scale;
    __device__ __forceinline__ void operator()(const f32x4 (&acc)[2][2][4][2], const Unit& u, int wr, int wc, int fr, int fq) const {
        const int row0 = u.pm * BM + wr * 64 + fr; const int col0 = u.pn * BM + wc * 32 + 8 * fq;
#pragma unroll
        for (int ai = 0; ai < 2; ++ai)
#pragma unroll
            for (int m = 0; m < 4; ++m) { const size_t row = (size_t)(row0 + ai * HALF + m * 16); const float rs = rsqrtf(rowss[row] * (1.f / 1024.f) + RMS_EPS) * scale;
#pragma unroll
                for (int bj = 0; bj < 2; ++bj) { const f32x4 v0 = acc[ai][bj][m][0] * rs, v1 = acc[ai][bj][m][1] * rs;
                    u32x4 w; w.x = cvt_pk_bf16(v0[0], v0[1]); w.y = cvt_pk_bf16(v0[2], v0[3]); w.z = cvt_pk_bf16(v1[0], v1[1]); w.w = cvt_pk_bf16(v1[2], v1[3]);
                    *(u32x4*)(out + row * 1024 + col0 + bj * HALF) = w; } }
    }
};
struct EpiSwiglu {
    static constexpr bool PERM = true, AFTER_DRAIN = false;
    const float* rowss; bf16_t* out;
    __device__ __forceinline__ void operator()(const f32x4 (&acc)[2][2][4][2], const Unit& u, int wr, int wc, int fr, int fq) const {
        const int row0 = u.pm * BM + wr * 64 + fr; const int col0 = u.pn * HALF + wc * 32 + 8 * fq;
#pragma unroll
        for (int ai = 0; ai < 2; ++ai)
#pragma unroll
            for (int m = 0; m < 4; ++m) { const size_t row = (size_t)(row0 + ai * HALF + m * 16); const float rs = rsqrtf(rowss[row] * (1.f / 1024.f) + RMS_EPS);
                float r[8];
#pragma unroll
                for (int n = 0; n < 2; ++n)
#pragma unroll
                    for (int e = 0; e < 4; ++e) r[4 * n + e] = fsilu(acc[ai][0][m][n][e] * rs) * (acc[ai][1][m][n][e] * rs);
                u32x4 w; w.x = cvt_pk_bf16(r[0], r[1]); w.y = cvt_pk_bf16(r[2], r[3]); w.z = cvt_pk_bf16(r[4], r[5]); w.w = cvt_pk_bf16(r[6], r[7]);
                *(u32x4*)(out + row * 2816 + col0) = w; }
    }
};

template <class Epi, class Sched, bool ALIGN_EPI = false, bool SP2 = false>
__device__ __forceinline__ void gemm_phase(PG8_LAS unsigned char* lds, const Gemm g, const Sched& S, const Epi& E) {
    const int tid = threadIdx.x, wid = __builtin_amdgcn_readfirstlane(tid >> 6), lane = tid & 63, wr = wid >> 2, wc = wid & 3, fr = lane & 15, fq = lane >> 4;
    const int K = g.K, nt = K / BK;
    unsigned voffA[2], voffB[2];
#pragma unroll
    for (int i = 0; i < 2; ++i) { int R, C; stage_rc(tid * 16 + i * 8192, R, C); const int Rb = Epi::PERM ? ((R & ~31) + perm32(R & 31)) : R;
        voffA[i] = (unsigned)(R * K + C) * 2u; voffB[i] = (unsigned)(Rb * K + C) * 2u; }
    const size_t kstep = (size_t)(BK * 2);
    const size_t hstep = (size_t)HALF * K * 2;
    const size_t tstep = 2 * hstep;
    const unsigned ldsw = (unsigned)wid * 1024u;
    const int aoff = lds_byte(wr * 64 + fr, fq * 8), boff = lds_byte(wc * 32 + fr, fq * 8);
#define PG8_SA(b, h) (((b) * 2 + (h)) * HTB)
#define PG8_SB(b, h) ((4 + (b) * 2 + (h)) * HTB)
#define PG8_STAGE(bufoff, gbase, voff) do { _Pragma("unroll") for (int _i = 0; _i < 2; ++_i) \
        __builtin_amdgcn_global_load_lds((const unsigned*)((const char*)(gbase) + (voff)[_i]), (PG8_LAS unsigned*)(lds + (bufoff) + ldsw + _i * 8192), 16, 0, 0); } while (0)
#define PG8_LDA(dst, b, h) do { _Pragma("unroll") for (int m = 0; m < 4; ++m) _Pragma("unroll") for (int k = 0; k < 2; ++k) dst[m][k] = *(const PG8_LAS bf16x8*)(lds + PG8_SA(b, h) + aoff + m * 2048 + k * 1024); } while (0)
#define PG8_LDB(dst, b, h) do { _Pragma("unroll") for (int n = 0; n < 2; ++n) _Pragma("unroll") for (int k = 0; k < 2; ++k) dst[n][k] = *(const PG8_LAS bf16x8*)(lds + PG8_SB(b, h) + boff + n * 2048 + k * 1024); } while (0)
#define PG8_MMA(ai, bj, At, Bt) do { __builtin_amdgcn_s_setprio(1); _Pragma("unroll") for (int m = 0; m < 4; ++m) _Pragma("unroll") for (int n = 0; n < 2; ++n) _Pragma("unroll") for (int k = 0; k < 2; ++k) \
        acc[ai][bj][m][n] = __builtin_amdgcn_mfma_f32_16x16x32_bf16(Bt[n][k], At[m][k], acc[ai][bj][m][n], 0, 0, 0); __builtin_amdgcn_s_setprio(0); } while (0)
#define PG8_WAIT_V(n) asm volatile("s_waitcnt vmcnt(" #n ")" ::: "memory")
#define PG8_WAIT_L(n) asm volatile("s_waitcnt lgkmcnt(" #n ")" ::: "memory")
#define PG8_BAR __builtin_amdgcn_s_barrier()
#define PG8_SCHED __builtin_amdgcn_sched_barrier(0)
    Unit cur, nxt; int ui = 0;
    if (!S.next(0, cur)) return;
    f32x4 acc[2][2][4][2];
#pragma unroll
    for (int a = 0; a < 2; ++a)
#pragma unroll
        for (int b = 0; b < 2; ++b)
#pragma unroll
            for (int m = 0; m < 4; ++m)
#pragma unroll
                for (int n = 0; n < 2; ++n) acc[a][b][m][n] = (f32x4){0.f, 0.f, 0.f, 0.f};
    bf16x8 At[4][2], B0[2][2], B1[2][2];
    const char* cA = (const char*)g.A + (size_t)cur.pm * tstep; const char* cB = (const char*)g.Bt + (size_t)cur.pn * tstep;
    S.a_ready(cur);
    if constexpr (SP2) {
        PG8_STAGE(PG8_SB(0, 0), cB, voffB); PG8_STAGE(PG8_SB(0, 1), cB + hstep, voffB); PG8_STAGE(PG8_SA(0, 0), cA, voffA); PG8_STAGE(PG8_SA(0, 1), cA + hstep, voffA);
        if (wr == 1) PG8_BAR;
        PG8_WAIT_V(2); PG8_BAR;
        PG8_STAGE(PG8_SB(1, 0), cB + kstep, voffB); PG8_STAGE(PG8_SA(1, 0), cA + kstep, voffA); PG8_STAGE(PG8_SB(1, 1), cB + hstep + kstep, voffB);
        PG8_WAIT_V(6); PG8_BAR;
    } else {
        PG8_STAGE(PG8_SB(0, 0), cB, voffB); PG8_STAGE(PG8_SA(0, 0), cA, voffA); PG8_STAGE(PG8_SB(0, 1), cB + hstep, voffB); PG8_STAGE(PG8_SA(0, 1), cA + hstep, voffA);
        if (wr == 1) PG8_BAR;
        PG8_WAIT_V(4); PG8_BAR;
        PG8_STAGE(PG8_SB(1, 0), cB + kstep, voffB); PG8_STAGE(PG8_SA(1, 0), cA + kstep, voffA); PG8_STAGE(PG8_SB(1, 1), cB + hstep + kstep, voffB);
        PG8_WAIT_V(6); PG8_BAR;
    }
    for (;;) {
        const bool has_next = S.next(ui + 1, nxt);
        const char* nA = has_next ? (const char*)g.A + (size_t)nxt.pm * tstep : cA; const char* nB = has_next ? (const char*)g.Bt + (size_t)nxt.pn * tstep : cB;
        for (int t = 0; t < nt; t += 2) {
            const bool last = (t == nt - 2);
            const char* a1 = cA + (size_t)(t + 1) * kstep;
            const char* a2 = last ? nA : cA + (size_t)(t + 2) * kstep; const char* b2 = last ? nB : cB + (size_t)(t + 2) * kstep;
            const char* a3 = a2 + kstep; const char* b3 = b2 + kstep;
            if (last && has_next) S.a_ready(nxt);
            if constexpr (SP2) {
            PG8_LDB(B0, 0, 0); PG8_LDB(B1, 0, 1); PG8_SCHED; PG8_LDA(At, 0, 0); PG8_STAGE(PG8_SA(1, 1), a1 + hstep, voffA);
            PG8_WAIT_V(8); PG8_WAIT_L(0); PG8_BAR; PG8_MMA(0, 0, At, B0); PG8_MMA(0, 1, At, B1); PG8_BAR; PG8_SCHED;
            PG8_LDA(At, 0, 1); PG8_STAGE(PG8_SB(0, 0), b2, voffB); PG8_STAGE(PG8_SB(0, 1), b2 + hstep, voffB); PG8_STAGE(PG8_SA(0, 0), a2, voffA);
            PG8_WAIT_V(8); PG8_WAIT_L(0); PG8_BAR; PG8_MMA(1, 0, At, B0); PG8_MMA(1, 1, At, B1); PG8_BAR; PG8_SCHED;
            PG8_LDB(B0, 1, 0); PG8_LDB(B1, 1, 1); PG8_SCHED; PG8_LDA(At, 1, 0); PG8_STAGE(PG8_SA(0, 1), a2 + hstep, voffA);
            PG8_WAIT_V(8); PG8_WAIT_L(0); PG8_BAR; PG8_MMA(0, 0, At, B0); PG8_MMA(0, 1, At, B1); PG8_BAR; PG8_SCHED;
            PG8_LDA(At, 1, 1); PG8_STAGE(PG8_SB(1, 0), b3, voffB); PG8_STAGE(PG8_SB(1, 1), b3 + hstep, voffB); PG8_STAGE(PG8_SA(1, 0), a3, voffA);
            PG8_WAIT_V(8); PG8_WAIT_L(0); PG8_BAR; PG8_MMA(1, 0, At, B0); PG8_MMA(1, 1, At, B1); PG8_BAR; PG8_SCHED;
            } else {
            PG8_LDB(B0, 0, 0); PG8_SCHED; PG8_LDA(At, 0, 0); PG8_STAGE(PG8_SA(1, 1), a1 + hstep, voffA);
            PG8_WAIT_L(8); PG8_BAR; PG8_WAIT_L(0); PG8_MMA(0, 0, At, B0); PG8_BAR; PG8_SCHED;
            PG8_LDB(B1, 0, 1); PG8_STAGE(PG8_SB(0, 0), b2, voffB);
            PG8_BAR; PG8_WAIT_L(0); PG8_MMA(0, 1, At, B1); PG8_BAR;
            PG8_LDA(At, 0, 1); PG8_STAGE(PG8_SA(0, 0), a2, voffA);
            PG8_BAR; PG8_WAIT_L(0); PG8_MMA(1, 0, At, B0); PG8_BAR; PG8_SCHED;
            PG8_STAGE(PG8_SB(0, 1), b2 + hstep, voffB);
            PG8_WAIT_V(6); PG8_BAR; PG8_MMA(1, 1, At, B1); PG8_BAR;
            PG8_LDB(B0, 1, 0); PG8_SCHED; PG8_LDA(At, 1, 0); PG8_STAGE(PG8_SA(0, 1), a2 + hstep, voffA);
            PG8_WAIT_L(8); PG8_BAR; PG8_WAIT_L(0); PG8_MMA(0, 0, At, B0); PG8_BAR; PG8_SCHED;
            PG8_LDB(B1, 1, 1); PG8_STAGE(PG8_SB(1, 0), b3, voffB);
            PG8_BAR; PG8_WAIT_L(0); PG8_MMA(0, 1, At, B1); PG8_BAR;
            PG8_LDA(At, 1, 1); PG8_STAGE(PG8_SA(1, 0), a3, voffA);
            PG8_BAR; PG8_WAIT_L(0); PG8_MMA(1, 0, At, B0); PG8_BAR; PG8_SCHED;
            PG8_STAGE(PG8_SB(1, 1), b3 + hstep, voffB);
            PG8_WAIT_V(6); PG8_BAR; PG8_MMA(1, 1, At, B1); PG8_BAR;
            }
        }
        if constexpr (ALIGN_EPI) { if (wr == 0) PG8_BAR; }
        if constexpr (!Epi::AFTER_DRAIN) { E(acc, cur, wr, wc, fr, fq); S.done(cur); }
        if (!has_next) break;
#pragma unroll
        for (int a = 0; a < 2; ++a)
#pragma unroll
            for (int b = 0; b < 2; ++b)
#pragma unroll
                for (int m = 0; m < 4; ++m)
#pragma unroll
                    for (int n = 0; n < 2; ++n) acc[a][b][m][n] = (f32x4){0.f, 0.f, 0.f, 0.f};
        cur = nxt; cA = nA; cB = nB; ++ui;
        if constexpr (ALIGN_EPI) { if (wr == 1) PG8_BAR; }
    }
    PG8_WAIT_V(0);
    if constexpr (!ALIGN_EPI) { if (wr == 0) PG8_BAR; }
    PG8_BAR;
    if constexpr (Epi::AFTER_DRAIN) { E.fused(acc, cur, wr, wc, fr, fq, lds, wid, lane); S.done(cur); }
#undef PG8_SA
#undef PG8_SB
#undef PG8_STAGE
#undef PG8_LDA
#undef PG8_LDB
#undef PG8_MMA
#undef PG8_WAIT_V
#undef PG8_WAIT_L
#undef PG8_BAR
#undef PG8_SCHED
}
}
#define LAS __attribute__((address_space(3)))
using pg8::bf16_t; using pg8::cvt_pk_bf16; using pg8::bf2f; using pg8::bflo; using pg8::bfhi; using pg8::fsigmoid; using pg8::fsilu; using pg8::RMS_EPS;
typedef short bf16x8 __attribute__((ext_vector_type(8)));
typedef short s16x4 __attribute__((ext_vector_type(4)));
typedef float f32x4 __attribute__((ext_vector_type(4)));
typedef float f32x16 __attribute__((ext_vector_type(16)));
typedef unsigned u32x4 __attribute__((ext_vector_type(4)));
typedef unsigned u32x2 __attribute__((ext_vector_type(2)));
#define MFMA32(a, b, c) __builtin_amdgcn_mfma_f32_32x32x16_bf16((a), (b), (c), 0, 0, 0)
#define MFMA16(a, b, c) __builtin_amdgcn_mfma_f32_16x16x32_bf16((a), (b), (c), 0, 0, 0)
#define DI __device__ __forceinline__
DI int crow(int reg, int h) { return (reg & 3) + 8 * (reg >> 2) + 4 * h; }
DI unsigned short f2bf(float f) { unsigned u = __float_as_uint(f); return (unsigned short)((u + 0x7fffu + ((u >> 16) & 1u)) >> 16); }
DI unsigned pk2(float lo, float hi) { return (unsigned)f2bf(lo) | ((unsigned)f2bf(hi) << 16); }
#define LDS_WAIT() asm volatile("s_waitcnt lgkmcnt(0)" ::: "memory")

#define RLX_AGENT __ATOMIC_RELAXED, __HIP_MEMORY_SCOPE_AGENT
#define XB_TMO      128
#define XB_XCNT(j)  (256  + 64 * (j))
#define XB_XSUB(j)  (1280 + 64 * (j))
#define XB_XGEN(j)  (2304 + 64 * (j))
#define XB_TOP      3328
#define XB_TOPGEN   3392
#define XCD_BAR_WORDS 3456
#define XB_SPIN_CAP (1u << 18)

__device__ __forceinline__ unsigned xb_ld(unsigned* p)              { return __hip_atomic_load(p, __ATOMIC_RELAXED, __HIP_MEMORY_SCOPE_AGENT); }
__device__ __forceinline__ unsigned xb_add(unsigned* p, unsigned v) { return __hip_atomic_fetch_add(p, v, __ATOMIC_RELAXED, __HIP_MEMORY_SCOPE_AGENT); }
__device__ __forceinline__ unsigned xb_xcc_id() { return (unsigned)__builtin_amdgcn_s_getreg((3 << 11) | 20) & 0xFu; }
#define XB_SPIN(cond, bar) do { unsigned _sp = 0; while (cond) { __builtin_amdgcn_s_sleep(1); \
    if ((++_sp & 255u) == 0u) { if (xb_ld(&(bar)[XB_TMO])) break; if (_sp > XB_SPIN_CAP) { atomicAdd(&(bar)[XB_TMO], 1u); break; } } } } while (0)

struct XcdBarrier {
    unsigned* bar; unsigned x;
    volatile LAS unsigned* st;
};

__device__ __forceinline__ XcdBarrier xcd_barrier_post(unsigned* bar, volatile LAS unsigned* st) {
    XcdBarrier b; b.bar = bar; b.x = xb_xcc_id(); b.st = st;
    if (threadIdx.x == 0) (void)xb_add(&bar[XB_XCNT(b.x)], 1u);
    return b;
}
__device__ __forceinline__ void xcd_barrier_complete(unsigned* bar, unsigned x, unsigned& nloc, unsigned& nx) {
    const unsigned G = gridDim.x * gridDim.y * gridDim.z;
    unsigned sum, cnt, mine, sp = 0u;
    for (;;) {
        sum = 0u; cnt = 0u; mine = 0u;
#pragma unroll
        for (unsigned j = 0; j < 16; ++j) { const unsigned c = xb_ld(&bar[XB_XCNT(j)]); sum += c; cnt += (c > 0u) ? 1u : 0u; mine = (j == x) ? c : mine; }
        if (sum == G) break;
        __builtin_amdgcn_s_sleep(1);
        if ((++sp & 255u) == 0u) { if (xb_ld(&bar[XB_TMO])) break; if (sp > XB_SPIN_CAP) { atomicAdd(&bar[XB_TMO], 1u); break; } }
    }
    nloc = mine > 0u ? mine : 1u; nx = cnt > 0u ? cnt : 1u;
}

__device__ __forceinline__ void xcd_barrier(const XcdBarrier& b) {
    asm volatile("s_waitcnt vmcnt(0)" ::: "memory");
    __syncthreads();
    if (threadIdx.x == 0) {
        unsigned* bar = b.bar;
        __builtin_amdgcn_s_waitcnt(0);
        unsigned nloc = b.st[0], nx = b.st[1];
        if (nloc == 0u) { xcd_barrier_complete(bar, b.x, nloc, nx); b.st[0] = nloc; b.st[1] = nx; }
        const unsigned old = xb_add(&bar[XB_XSUB(b.x)], 1u);
        const unsigned gen = old / nloc;
        if (old + 1u == (gen + 1u) * nloc) {
            __builtin_amdgcn_fence(__ATOMIC_RELEASE, "agent");
            asm volatile("s_waitcnt vmcnt(0)" ::: "memory");
            const unsigned og = xb_add(&bar[XB_TOP], 1u);
            const unsigned tg = og / nx;
            if (og + 1u == (tg + 1u) * nx) xb_add(&bar[XB_TOPGEN], 1u);
            else XB_SPIN(xb_ld(&bar[XB_TOPGEN]) == tg, bar);
            __builtin_amdgcn_fence(__ATOMIC_ACQUIRE, "agent");
            xb_add(&bar[XB_XGEN(b.x)], 1u);
            asm volatile("s_waitcnt vmcnt(0)" ::: "memory");
        } else {
            XB_SPIN(xb_ld(&bar[XB_XGEN(b.x)]) == gen, bar);
            __builtin_amdgcn_fence(__ATOMIC_ACQUIRE, "agent");
            asm volatile("s_waitcnt vmcnt(0)" ::: "memory");
        }
    }
    __syncthreads();
}

constexpr int NWAVES = 8, NTHR = 512;
constexpr int BATCH = 2, T = 8192, D = 1024, M = BATCH * T, NMEM = 256, DFF = 2816;
constexpr size_t MiB = 1u << 20;
constexpr size_t WS_BAR = 212992;
constexpr size_t WS_ROWSS1 = 0, WS_ROWSS2 = 65536, WS_ROWSS3 = 131072, CTL_ZERO_BYTES = 262144;
constexpr size_t WS_MEMN = 1 * MiB, WS_MK = 2 * MiB, WS_MVT = 3 * MiB;
constexpr size_t WS_WMAIN = 4 * MiB, WS_WSWAP = 13 * MiB, WS_WA = 15 * MiB, WS_WB = 16 * MiB, WS_WOUT = 17 * MiB, WS_WXQ = 19 * MiB, WS_WXK = 21 * MiB, WS_WXV = 23 * MiB,
                 WS_WXO = 25 * MiB, WS_WFI = 27 * MiB, WS_WFO = 38 * MiB;
constexpr size_t WS_QA = 44 * MiB, WS_GA = 60 * MiB, WS_LF = 76 * MiB, WS_VT = 108 * MiB, WS_GATE = 140 * MiB, WS_U = 204 * MiB, WS_YA = 236 * MiB, WS_GAM = 252 * MiB;
constexpr size_t WS_T1 = 44 * MiB, WS_MERGED = 76 * MiB, WS_X1B = 108 * MiB, WS_XQ = 44 * MiB, WS_XO = 76 * MiB, WS_X2B = 108 * MiB, WS_FFH = 140 * MiB;
constexpr size_t WS_END = 256 * MiB;
constexpr size_t DO_H1 = 0, DO_QB = 32 * MiB, DO_KB = 48 * MiB, DO_YB = 0;
constexpr int LDS_BYTES = 147456;

DI float wave_sum(float v) {
#pragma unroll
    for (int o = 1; o < 64; o <<= 1) v += __shfl_xor(v, o);
    return v;
}
DI void p0_transpose_item(const float* W, int K, int N, bf16_t* dst, const float* gk, LAS float* scr, int k0, int n0, int lane) {
#pragma unroll 8
    for (int i = 0; i < 32; ++i) { const int kk = 2 * i + (lane >> 5); float w = W[(size_t)(k0 + kk) * N + n0 + (lane & 31)]; if (gk) w *= gk[k0 + kk]; scr[kk * 33 + (lane & 31)] = w; }
    LDS_WAIT();
    const int c = lane & 7;
#pragma unroll
    for (int j = 0; j < 4; ++j) { const int n = (lane >> 3) + 8 * j; const LAS float* s = scr + (8 * c) * 33 + n;
        u32x4 o; o.x = pk2(s[0 * 33], s[1 * 33]); o.y = pk2(s[2 * 33], s[3 * 33]); o.z = pk2(s[4 * 33], s[5 * 33]); o.w = pk2(s[6 * 33], s[7 * 33]);
        *(u32x4*)(dst + (size_t)n * K + k0 + 8 * c) = o; }
    LDS_WAIT();
}
DI void rms_row_to_bf16(const float* xrow, const float* g, bf16_t* orow, int lane) {
    const f32x4* xr = (const f32x4*)xrow + lane; const f32x4* gr = (const f32x4*)g + lane;
    f32x4 v[4]; float s = 0.f;
#pragma unroll
    for (int j = 0; j < 4; ++j) { v[j] = xr[64 * j]; s += (v[j].x * v[j].x + v[j].y * v[j].y) + (v[j].z * v[j].z + v[j].w * v[j].w); }
    const float rstd = rsqrtf(wave_sum(s) * (1.f / 1024.f) + RMS_EPS);
    unsigned long long* o8 = (unsigned long long*)orow + lane;
#pragma unroll
    for (int j = 0; j < 4; ++j) { const f32x4 gg = gr[64 * j];
        o8[64 * j] = (unsigned long long)pk2(v[j].x * rstd * gg.x, v[j].y * rstd * gg.y) | ((unsigned long long)pk2(v[j].z * rstd * gg.z, v[j].w * rstd * gg.w) << 32); }
}

DI void hgrn_a_item(LAS unsigned char* lds, int item, const float* LF, const bf16_t* VT, bf16_t* U, float* GAM) {
    const int tid = threadIdx.x, lane = tid & 63, wave = tid >> 6;
    const int bh = item >> 7, c = item & 127, b = bh >> 2, h = bh & 3;
    const size_t row0 = (size_t)b * T + c * 64;
    LAS float* PT = (LAS float*)(lds + 32768);
    LAS bf16_t* KT = (LAS bf16_t*)(lds + 34816);
    const int d = tid & 127, part = tid >> 7;
    float lf[16], bb[16];
#pragma unroll
    for (int j = 0; j < 16; ++j) lf[j] = LF[(row0 + part * 16 + j) * 512 + h * 128 + d];
    float run = 0.f;
#pragma unroll
    for (int j = 0; j < 16; ++j) { run += lf[j]; bb[j] = run; }
    PT[part * 128 + d] = run;
    __syncthreads();
    float off = 0.f, tot = 0.f;
#pragma unroll
    for (int p = 0; p < 4; ++p) { const float v = PT[p * 128 + d]; if (p < part) off += v; tot += v; }
    unsigned pk[8];
#pragma unroll
    for (int j = 0; j < 16; j += 2) { const float k0 = (1.f - __expf(lf[j])) * __expf(tot - (bb[j] + off)), k1 = (1.f - __expf(lf[j + 1])) * __expf(tot - (bb[j + 1] + off)); pk[j >> 1] = cvt_pk_bf16(k0, k1); }
    LAS u32x4* dst = (LAS u32x4*)(KT + d * 72 + part * 16);
    dst[0] = (u32x4){pk[0], pk[1], pk[2], pk[3]}; dst[1] = (u32x4){pk[4], pk[5], pk[6], pk[7]};
    if (part == 0) GAM[(size_t)item * 128 + d] = __expf(tot);
    __syncthreads();
    const int r = lane & 31, hh = lane >> 5, mt = wave >> 1, ntb = (wave & 1) * 2;
    f32x16 acc0, acc1;
#pragma unroll
    for (int i = 0; i < 16; ++i) { acc0[i] = 0.f; acc1[i] = 0.f; }
    const bf16_t* vrow = VT + (size_t)(h * 128 + mt * 32 + r) * M + row0 + 8 * hh;
#pragma unroll
    for (int s = 0; s < 4; ++s) { const bf16x8 a = *(const bf16x8*)(vrow + 16 * s);
        const bf16x8 b0 = *(const LAS bf16x8*)(KT + (ntb * 32 + r) * 72 + 16 * s + 8 * hh), b1 = *(const LAS bf16x8*)(KT + ((ntb + 1) * 32 + r) * 72 + 16 * s + 8 * hh);
        acc0 = MFMA32(a, b0, acc0); acc1 = MFMA32(a, b1, acc1); }
    bf16_t* up = U + (size_t)item * 16384;
#pragma unroll
    for (int i = 0; i < 16; ++i) { const int v = mt * 32 + crow(i, hh); up[v * 128 + ntb * 32 + r] = f2bf(acc0[i]); up[v * 128 + (ntb + 1) * 32 + r] = f2bf(acc1[i]); }
    __syncthreads();
}
DI void hgrn_scan(bf16_t* U, bf16_t* SD, const float* GAM, int G) {
    const int tid = threadIdx.x;
    if (tid >= 256) return;
    for (int e = blockIdx.x * 256 + tid; e < 65536; e += G * 256) {
        const int bh = e >> 13, rem = e & 8191;
        float s0 = 0.f, s1 = 0.f;
        unsigned* up = (unsigned*)(U + (size_t)bh * 128 * 16384) + rem; unsigned* sp = (unsigned*)(SD + (size_t)bh * 128 * 16384) + rem;
        const float* gp = GAM + (size_t)bh * 128 * 128 + ((rem * 2) & 127);
        for (int c0 = 0; c0 < 128; c0 += 8) {
            unsigned uu[8]; float g0[8], g1[8];
#pragma unroll
            for (int j = 0; j < 8; ++j) { uu[j] = up[(size_t)(c0 + j) * 8192]; g0[j] = gp[(c0 + j) * 128]; g1[j] = gp[(c0 + j) * 128 + 1]; }
#pragma unroll
            for (int j = 0; j < 8; ++j) { sp[(size_t)(c0 + j) * 8192] = pk2(s0, s1); s0 = g0[j] * s0 + bflo(uu[j]); s1 = g1[j] * s1 + bfhi(uu[j]); }
        }
    }
}
DI void hgrn_e_item(LAS unsigned char* lds, int item, const float* LF, const bf16_t* QA, const bf16_t* GA, const bf16_t* VT, const bf16_t* SST, const float* g_hgrn, bf16_t* YA) {
    const int tid = threadIdx.x, lane = tid & 63, wave = tid >> 6;
    const int bh = item >> 7, c = item & 127, b = bh >> 2, h = bh & 3;
    const size_t row0 = (size_t)b * T + c * 64;
    LAS float* PT = (LAS float*)(lds + 32768);
    LAS bf16_t* QT = (LAS bf16_t*)(lds + 34816);
    LAS bf16_t* QD = (LAS bf16_t*)(lds + 52224);
    LAS bf16_t* KD = (LAS bf16_t*)(lds + 69632);
    LAS bf16_t* SC = (LAS bf16_t*)(lds + 113152);
    LAS float* SSQ = (LAS float*)(lds + 122368);
    const int d = tid & 127, part = tid >> 7;
    float lf[16], bb[16];
#pragma unroll
    for (int j = 0; j < 16; ++j) lf[j] = LF[(row0 + part * 16 + j) * 512 + h * 128 + d];
    float run = 0.f;
#pragma unroll
    for (int j = 0; j < 16; ++j) { run += lf[j]; bb[j] = run; }
    PT[part * 128 + d] = run;
    for (int u = tid; u < 2304; u += NTHR) ((LAS unsigned*)SC)[u] = 0u;
    __syncthreads();
    const float B1 = PT[d], B2 = B1 + PT[128 + d], B3 = B2 + PT[256 + d];
    const float off = part == 0 ? 0.f : (part == 1 ? B1 : (part == 2 ? B2 : B3));
#pragma unroll
    for (int j = 0; j < 16; ++j) {
        const int t = part * 16 + j; const float bt = bb[j] + off;
        const float q = bf2f(QA[(row0 + t) * 512 + h * 128 + d]);
        QT[t * 136 + d] = f2bf(q * __expf(bt)); QD[t * 136 + d] = f2bf(q * __expf(bb[j]));
        const float k = 1.f - __expf(lf[j]);
#pragma unroll
        for (int ip = 0; ip < 4; ++ip) if (ip >= part) { const float beta = ip == 0 ? 0.f : (ip == 1 ? B1 : (ip == 2 ? B2 : B3));
            KD[(8 * ip * (ip + 1) + t) * 136 + d] = f2bf(k * __expf(beta - bt)); }
    }
    __syncthreads();
    for (int tile = wave; tile < 10; tile += 8) {
        const int i = tile >= 6 ? 3 : (tile >= 3 ? 2 : (tile >= 1 ? 1 : 0)), j = tile - (i * (i + 1)) / 2, base = 8 * i * (i + 1);
        const int r16 = lane & 15, q4 = lane >> 4;
        f32x4 sc = {0.f, 0.f, 0.f, 0.f};
#pragma unroll
        for (int s = 0; s < 4; ++s) { const bf16x8 a = *(const LAS bf16x8*)(QD + (16 * i + r16) * 136 + 32 * s + 8 * q4), bq = *(const LAS bf16x8*)(KD + (base + 16 * j + r16) * 136 + 32 * s + 8 * q4);
            sc = MFMA16(a, bq, sc); }
#pragma unroll
        for (int jj = 0; jj < 4; ++jj) { const int tl = 4 * q4 + jj; const bool ok = (j < i) || (r16 <= tl); SC[(16 * i + tl) * 72 + 16 * j + r16] = ok ? f2bf(sc[jj]) : (unsigned short)0; }
    }
    __syncthreads();
    const int mt = wave >> 2, nt = wave & 3, r = lane & 31, hh = lane >> 5;
    f32x16 o;
#pragma unroll
    for (int i = 0; i < 16; ++i) o[i] = 0.f;
    const bf16_t* sst = SST + (size_t)item * 16384 + (32 * nt + r) * 128 + 8 * hh;
#pragma unroll
    for (int s = 0; s < 8; ++s) { const bf16x8 a = *(const LAS bf16x8*)(QT + (32 * mt + r) * 136 + 16 * s + 8 * hh); const bf16x8 bs = *(const bf16x8*)(sst + 16 * s); o = MFMA32(a, bs, o); }
    const bf16_t* vt = VT + (size_t)(h * 128 + 32 * nt + r) * M + row0 + 8 * hh;
#pragma unroll
    for (int s = 0; s < 4; ++s) { const bf16x8 a = *(const LAS bf16x8*)(SC + (32 * mt + r) * 72 + 16 * s + 8 * hh); const bf16x8 bv = *(const bf16x8*)(vt + 16 * s); o = MFMA32(a, bv, o); }
#pragma unroll
    for (int i = 0; i < 16; ++i) { float s = o[i] * o[i];
        s += __shfl_xor(s, 1); s += __shfl_xor(s, 2); s += __shfl_xor(s, 4); s += __shfl_xor(s, 8); s += __shfl_xor(s, 16);
        if (r == 0) SSQ[(32 * mt + crow(i, hh)) * 4 + nt] = s; }
    __syncthreads();
    const int v = 32 * nt + r; const float gh = g_hgrn[h * 128 + v];
#pragma unroll
    for (int i = 0; i < 16; ++i) { const int t = 32 * mt + crow(i, hh);
        const float ss = (SSQ[t * 4] + SSQ[t * 4 + 1]) + (SSQ[t * 4 + 2] + SSQ[t * 4 + 3]); const float rstd = rsqrtf(ss * (1.f / 128.f) + RMS_EPS);
        const size_t off2 = (row0 + t) * 512 + h * 128 + v;
        YA[off2] = f2bf(o[i] * rstd * gh * bf2f(GA[off2])); }
    __syncthreads();
}
DI void sb_wave_item(LAS unsigned char* wl, int wi, const bf16_t* QB, const bf16_t* KB, const bf16_t* VT, bf16_t* YB) {
    const int lane = threadIdx.x & 63, r = lane & 31, hh = lane >> 5;
    const int b = wi >> 11, h = (wi >> 8) & 7, qb = wi & 255, t0 = qb * 32;
    const size_t rowb = (size_t)b * T;
    bf16x8 qf[4];
    { const bf16_t* qp = QB + (rowb + t0 + r) * 512 + h * 64 + 8 * hh;
#pragma unroll
      for (int s = 0; s < 4; ++s) qf[s] = *(const bf16x8*)(qp + 16 * s); }
    f32x16 o0, o1;
#pragma unroll
    for (int i = 0; i < 16; ++i) { o0[i] = 0.f; o1[i] = 0.f; }
    float carry = 0.f;
    const bf16_t* vt0 = VT + (size_t)(512 + h * 64 + r) * M + rowb + 4 * hh; const bf16_t* vt1 = vt0 + (size_t)32 * M;
    for (int kt = qb; kt >= 0; --kt) {
        const int key0 = kt * 32;
        const bf16_t* kp = KB + (rowb + key0 + r) * 512 + h * 64 + 8 * hh;
        f32x16 z;
#pragma unroll
        for (int i = 0; i < 16; ++i) z[i] = 0.f;
#pragma unroll
        for (int s = 0; s < 4; ++s) z = MFMA32(*(const bf16x8*)(kp + 16 * s), qf[s], z);
        s16x4 va0[2][2], va1[2][2];
#pragma unroll
        for (int s = 0; s < 2; ++s)
#pragma unroll
            for (int hf = 0; hf < 2; ++hf) { va0[s][hf] = *(const s16x4*)(vt0 + key0 + 16 * s + 8 * hf); va1[s][hf] = *(const s16x4*)(vt1 + key0 + 16 * s + 8 * hf); }
        const bool diag = (kt == qb);
        float sp[16];
#pragma unroll
        for (int i = 0; i < 16; ++i) { const float zi = z[i]; const bool valid = !diag || (crow(i, hh) < r);
            const float spv = fmaxf(zi, 0.f) + __logf(1.f + __expf(-fabsf(zi))); sp[i] = valid ? spv : 0.f; }
        float Gs[4], PG[4];
#pragma unroll
        for (int g = 0; g < 4; ++g) { Gs[g] = (sp[4 * g] + sp[4 * g + 1]) + (sp[4 * g + 2] + sp[4 * g + 3]); PG[g] = __shfl_xor(Gs[g], 32); }
        float R[4]; R[3] = 0.f; R[2] = Gs[3] + PG[3]; R[1] = R[2] + (Gs[2] + PG[2]); R[0] = R[1] + (Gs[1] + PG[1]);
        const float tot = R[0] + (Gs[0] + PG[0]);
        float av[16];
#pragma unroll
        for (int g = 0; g < 4; ++g) { const float after = carry + R[g] + (hh == 0 ? PG[g] : 0.f);
            float ins = 0.f;
#pragma unroll
            for (int e = 3; e >= 0; --e) { const int i = 4 * g + e; ins += sp[i]; const bool valid = !diag || (crow(i, hh) < r);
                av[i] = valid ? __expf(z[i] - (after + ins)) : 0.f; } }
        carry += tot;
        u32x4 p0, p1;
        p0.x = cvt_pk_bf16(av[0], av[1]); p0.y = cvt_pk_bf16(av[2], av[3]); p0.z = cvt_pk_bf16(av[4], av[5]); p0.w = cvt_pk_bf16(av[6], av[7]);
        p1.x = cvt_pk_bf16(av[8], av[9]); p1.y = cvt_pk_bf16(av[10], av[11]); p1.z = cvt_pk_bf16(av[12], av[13]); p1.w = cvt_pk_bf16(av[14], av[15]);
        const bf16x8 pb0 = __builtin_bit_cast(bf16x8, p0), pb1 = __builtin_bit_cast(bf16x8, p1);
        o0 = MFMA32(__builtin_shufflevector(va0[0][0], va0[0][1], 0, 1, 2, 3, 4, 5, 6, 7), pb0, o0);
        o0 = MFMA32(__builtin_shufflevector(va0[1][0], va0[1][1], 0, 1, 2, 3, 4, 5, 6, 7), pb1, o0);
        o1 = MFMA32(__builtin_shufflevector(va1[0][0], va1[0][1], 0, 1, 2, 3, 4, 5, 6, 7), pb0, o1);
        o1 = MFMA32(__builtin_shufflevector(va1[1][0], va1[1][1], 0, 1, 2, 3, 4, 5, 6, 7), pb1, o1);
        if (__all(carry > 104.f)) break;
    }
    LAS bf16_t* OL = (LAS bf16_t*)wl;
#pragma unroll
    for (int i = 0; i < 16; ++i) { OL[r * 72 + crow(i, hh)] = f2bf(o0[i]); OL[r * 72 + 32 + crow(i, hh)] = f2bf(o1[i]); }
    LDS_WAIT();
    { const int row = lane >> 1, half = lane & 1; bf16_t* gp = YB + (rowb + t0 + row) * 512 + h * 64 + half * 32;
#pragma unroll
      for (int k = 0; k < 4; ++k) *(u32x4*)(gp + 8 * k) = *(const LAS u32x4*)(OL + row * 72 + half * 32 + 8 * k); }
    LDS_WAIT();
}
DI void xattn_item(LAS unsigned char* lds, int item, const bf16_t* XQ, const bf16_t* MK, const bf16_t* MVT, bf16_t* XO) {
    const int tid = threadIdx.x, lane = tid & 63, wave = tid >> 6, r = lane & 31, hh = lane >> 5;
    const int b = item >> 7, h = (item >> 5) & 3, tile = item & 31;
    const size_t rowq = (size_t)b * T + tile * 256 + wave * 32;
    constexpr int RS = 528;
    LAS unsigned char* ring = lds;
    LAS bf16_t* OL = (LAS bf16_t*)(lds + 67584 + wave * 4608);
    const int srow = tid >> 5, sc16 = tid & 31;
    const bf16_t* kbase = MK + (size_t)(b * NMEM + srow) * 1024 + h * 256 + sc16 * 8;
    const bf16_t* vbase = MVT + (size_t)(h * 256 + srow) * 512 + b * NMEM + sc16 * 8;
    u32x4 st[4];
#define XA_LOAD(ch) do { _Pragma("unroll") for (int i_ = 0; i_ < 4; ++i_) st[i_] = ((ch) < 4) ? *(const u32x4*)(kbase + (size_t)(64 * (ch) + 16 * i_) * 1024) : *(const u32x4*)(vbase + (size_t)(64 * ((ch) - 4) + 16 * i_) * 512); } while (0)
#define XA_LOADV(ch) do { _Pragma("unroll") for (int i_ = 0; i_ < 4; ++i_) st[i_] = *(const u32x4*)(vbase + (size_t)(64 * ((ch) - 4) + 16 * i_) * 512); } while (0)
#define XA_WRITE(ch) do { _Pragma("unroll") for (int i_ = 0; i_ < 4; ++i_) *(LAS u32x4*)(ring + ((ch) & 1) * 33792 + (srow + 16 * i_) * RS + sc16 * 16) = st[i_]; } while (0)
    XA_LOAD(0);
    bf16x8 qf[16];
    { const bf16_t* qp = XQ + (rowq + r) * 1024 + h * 256 + 8 * hh;
#pragma unroll
      for (int s = 0; s < 16; ++s) qf[s] = *(const bf16x8*)(qp + 16 * s); }
    XA_WRITE(0);
    __syncthreads();
    bf16x8 P[8][2];
    float mh[4], sh[4];
#pragma unroll
    for (int ch = 0; ch < 4; ++ch) {
        f32x16 S[2];
        XA_LOAD(ch + 1);
        const LAS unsigned char* buf = ring + (ch & 1) * 33792;
#pragma unroll
        for (int m2 = 0; m2 < 2; ++m2) {
            f32x16 acc;
#pragma unroll
            for (int i = 0; i < 16; ++i) acc[i] = 0.f;
#pragma unroll
            for (int s = 0; s < 16; ++s) { acc = MFMA32(*(const LAS bf16x8*)(buf + (32 * m2 + r) * RS + (16 * s + 8 * hh) * 2), qf[s], acc); if ((s & 3) == 3) __builtin_amdgcn_sched_barrier(0); }
            S[m2] = acc;
        }
        XA_WRITE(ch + 1);
        float mx = -3.0e38f;
#pragma unroll
        for (int mt = 0; mt < 2; ++mt)
#pragma unroll
            for (int i = 0; i < 16; ++i) mx = fmaxf(mx, S[mt][i]);
        mx = fmaxf(mx, __shfl_xor(mx, 32));
        float sum = 0.f;
#pragma unroll
        for (int mt = 0; mt < 2; ++mt) {
            float p[16];
#pragma unroll
            for (int i = 0; i < 16; ++i) { p[i] = __expf(S[mt][i] - mx); sum += p[i]; }
            u32x4 p0, p1;
            p0.x = cvt_pk_bf16(p[0], p[1]); p0.y = cvt_pk_bf16(p[2], p[3]); p0.z = cvt_pk_bf16(p[4], p[5]); p0.w = cvt_pk_bf16(p[6], p[7]);
            p1.x = cvt_pk_bf16(p[8], p[9]); p1.y = cvt_pk_bf16(p[10], p[11]); p1.z = cvt_pk_bf16(p[12], p[13]); p1.w = cvt_pk_bf16(p[14], p[15]);
            P[2 * ch + mt][0] = __builtin_bit_cast(bf16x8, p0); P[2 * ch + mt][1] = __builtin_bit_cast(bf16x8, p1);
        }
        sum += __shfl_xor(sum, 32);
        mh[ch] = mx; sh[ch] = sum;
        __syncthreads();
    }
    const float mfin = fmaxf(fmaxf(mh[0], mh[1]), fmaxf(mh[2], mh[3]));
    float fq[4]; float den = 0.f;
#pragma unroll
    for (int q = 0; q < 4; ++q) { fq[q] = __expf(mh[q] - mfin); den += fq[q] * sh[q]; }
    const float inv = 1.f / den;
#pragma unroll
    for (int q = 0; q < 4; ++q) fq[q] *= inv;
#pragma unroll 1
    for (int ch = 4; ch < 8; ++ch) {
        if (ch < 7) XA_LOADV(ch + 1);
        const LAS unsigned char* buf = ring + (ch & 1) * 33792;
#pragma unroll 1
        for (int d2 = 0; d2 < 2; ++d2) {
            f32x16 O[4];
#pragma unroll
            for (int q = 0; q < 4; ++q)
#pragma unroll
                for (int i = 0; i < 16; ++i) O[q][i] = 0.f;
#pragma unroll
            for (int q = 0; q < 4; ++q)
#pragma unroll
                for (int m2 = 0; m2 < 2; ++m2)
#pragma unroll
                    for (int s = 0; s < 2; ++s) { const LAS unsigned char* vp = buf + (32 * d2 + r) * RS + (32 * (2 * q + m2) + 16 * s + 4 * hh) * 2;
                        const s16x4 lo = *(const LAS s16x4*)vp, hi = *(const LAS s16x4*)(vp + 16);
                        O[q] = MFMA32(__builtin_shufflevector(lo, hi, 0, 1, 2, 3, 4, 5, 6, 7), P[2 * q + m2][s], O[q]); if (s == 1) __builtin_amdgcn_sched_barrier(0); }
#pragma unroll
            for (int i = 0; i < 16; ++i) OL[r * 72 + 32 * d2 + crow(i, hh)] = f2bf((O[0][i] * fq[0] + O[1][i] * fq[1]) + (O[2][i] * fq[2] + O[3][i] * fq[3]));
            __builtin_amdgcn_sched_barrier(0);
        }
        LDS_WAIT();
        { const int row = lane >> 1, half = lane & 1; bf16_t* gp = XO + (rowq + row) * 1024 + h * 256 + 64 * (ch - 4) + half * 32;
#pragma unroll
          for (int k = 0; k < 4; ++k) *(u32x4*)(gp + 8 * k) = *(const LAS u32x4*)(OL + row * 72 + half * 32 + 8 * k); }
        LDS_WAIT();
        if (ch < 7) XA_WRITE(ch + 1);
        __syncthreads();
    }
#undef XA_LOAD
#undef XA_LOADV
#undef XA_WRITE
}

constexpr int NPHASE = 13;
struct Args { const float* in[19]; float* out; unsigned char* ws; int ph_lo, ph_hi, probe, pad; };
#ifndef MK_ONE_LAUNCH
#define MK_ONE_LAUNCH 1
#endif

__global__ void __launch_bounds__(NTHR, 2) fwd_kernel(Args args) {
    extern __shared__ __attribute__((aligned(16))) unsigned char lds_raw[];
    LAS unsigned char* lds = (LAS unsigned char*)lds_raw;
    const int tid = threadIdx.x, lane = tid & 63, wave = __builtin_amdgcn_readfirstlane(tid >> 6);
    const int G = gridDim.x, bx = blockIdx.x;
    unsigned char* ws = args.ws; unsigned char* dob = (unsigned char*)args.out;
    const float* x = args.in[0]; const float* mem = args.in[1]; const float* g_mix = args.in[2]; const float* w_in = args.in[3]; const float* lb_table = args.in[4];
    const float* g_hgrn = args.in[5]; const float* w_gate = args.in[6]; const float* w_pa = args.in[7]; const float* w_pb = args.in[8]; const float* w_out = args.in[9];
    const float* g_xattn = args.in[10]; const float* g_mem = args.in[11]; const float* w_xq = args.in[12]; const float* w_xkv = args.in[13]; const float* w_xo = args.in[14];
    const float* g_ffn = args.in[15]; const float* w_ffn_in = args.in[16]; const float* w_ffn_out = args.in[17]; const float* g_final = args.in[18];
    float* ROWSS1 = (float*)(ws + WS_ROWSS1); float* ROWSS2 = (float*)(ws + WS_ROWSS2); float* ROWSS3 = (float*)(ws + WS_ROWSS3);
    bf16_t* MEMN = (bf16_t*)(ws + WS_MEMN); bf16_t* MK = (bf16_t*)(ws + WS_MK); bf16_t* MVT = (bf16_t*)(ws + WS_MVT);
    bf16_t* WMAIN = (bf16_t*)(ws + WS_WMAIN); bf16_t* WSWAP = (bf16_t*)(ws + WS_WSWAP); bf16_t* WA = (bf16_t*)(ws + WS_WA); bf16_t* WB = (bf16_t*)(ws + WS_WB);
    bf16_t* WOUT = (bf16_t*)(ws + WS_WOUT); bf16_t* WXQ = (bf16_t*)(ws + WS_WXQ); bf16_t* WXK = (bf16_t*)(ws + WS_WXK); bf16_t* WXV = (bf16_t*)(ws + WS_WXV);
    bf16_t* WXO = (bf16_t*)(ws + WS_WXO); bf16_t* WFI = (bf16_t*)(ws + WS_WFI); bf16_t* WFO = (bf16_t*)(ws + WS_WFO);
    bf16_t* QA = (bf16_t*)(ws + WS_QA); bf16_t* GA = (bf16_t*)(ws + WS_GA); float* LF = (float*)(ws + WS_LF); bf16_t* VT = (bf16_t*)(ws + WS_VT);
    bf16_t* GATE = (bf16_t*)(ws + WS_GATE); bf16_t* U = (bf16_t*)(ws + WS_U); bf16_t* YA = (bf16_t*)(ws + WS_YA); float* GAM = (float*)(ws + WS_GAM);
    bf16_t* T1 = (bf16_t*)(ws + WS_T1); bf16_t* MERGED = (bf16_t*)(ws + WS_MERGED); bf16_t* X1B = (bf16_t*)(ws + WS_X1B); bf16_t* XQ = (bf16_t*)(ws + WS_XQ);
    bf16_t* XO = (bf16_t*)(ws + WS_XO); bf16_t* X2B = (bf16_t*)(ws + WS_X2B); bf16_t* FFH = (bf16_t*)(ws + WS_FFH);
    bf16_t* H1 = (bf16_t*)(dob + DO_H1); bf16_t* QB = (bf16_t*)(dob + DO_QB); bf16_t* KB = (bf16_t*)(dob + DO_KB); bf16_t* YB = (bf16_t*)(dob + DO_YB);
    float* XR = args.out;

    volatile LAS unsigned* MISC = (volatile LAS unsigned*)(lds + 147392);
    if (tid < 16) MISC[tid] = 0u;
    __syncthreads();
    XcdBarrier bar; bar.bar = (unsigned*)(ws + WS_BAR); bar.x = 0; bar.st = MISC;
    if (args.ph_hi - args.ph_lo > 1) bar = xcd_barrier_post((unsigned*)(ws + WS_BAR), MISC);
    if (args.probe == 0x7fffffff) cg::this_grid().sync();
    const int lo = args.ph_lo, hi = args.ph_hi; const bool pr = args.probe != 0;
    float* PRO = (float*)(ws + 140 * MiB); bf16_t* PRB = (bf16_t*)(ws + 204 * MiB); float* PRS = (float*)(ws + 196608);
#define IN(k) (lo <= (k) && (k) < hi)
#define SEAM(k) do { if (IN(k) && IN((k) + 1)) xcd_barrier(bar); } while (0)

    if (IN(0)) {
        LAS float* scr = (LAS float*)(lds + wave * 16384);
        const int gw = bx * NWAVES + wave, NGW = G * NWAVES;
        constexpr int I_IN = 16 * 112, I_GATE = 16 * 64, I_A = 8 * 32, I_B = 8 * 32, I_OUT = 16 * 32, I_XQ = 16 * 32, I_XKV = 16 * 64, I_XO = 16 * 32, I_FI = 16 * 176, I_FO = 44 * 32;
        constexpr int NITEMS = I_IN + I_GATE + I_A + I_B + I_OUT + I_XQ + I_XKV + I_XO + I_FI + I_FO;
        for (int it = gw; it < NITEMS; it += NGW) {
            int r = it;
            if (r < I_IN) { const int nblk = 112, k0 = 64 * (r / nblk), n0 = 32 * (r % nblk), seg = n0 >> 9;
                bf16_t* dst = (seg < 2) ? WMAIN + (size_t)n0 * 1024 : (seg == 2) ? WSWAP + (size_t)(n0 - 1024) * 1024 : (seg < 6) ? WMAIN + (size_t)(n0 - 512) * 1024 : WSWAP + (size_t)(n0 - 3072 + 512) * 1024;
                p0_transpose_item(w_in, 1024, 3584, dst, nullptr, scr, k0, n0, lane); continue; } r -= I_IN;
            if (r < I_GATE) { const int nblk = 64, k0 = 64 * (r / nblk), n0 = 32 * (r % nblk); p0_transpose_item(w_gate, 1024, 2048, WMAIN + (size_t)(2560 + n0) * 1024, nullptr, scr, k0, n0, lane); continue; } r -= I_GATE;
            if (r < I_A) { const int nblk = 32, k0 = 64 * (r / nblk), n0 = 32 * (r % nblk); p0_transpose_item(w_pa, 512, 1024, WA + (size_t)n0 * 512, nullptr, scr, k0, n0, lane); continue; } r -= I_A;
            if (r < I_B) { const int nblk = 32, k0 = 64 * (r / nblk), n0 = 32 * (r % nblk); p0_transpose_item(w_pb, 512, 1024, WB + (size_t)n0 * 512, nullptr, scr, k0, n0, lane); continue; } r -= I_B;
            if (r < I_OUT) { const int nblk = 32, k0 = 64 * (r / nblk), n0 = 32 * (r % nblk); p0_transpose_item(w_out, 1024, 1024, WOUT + (size_t)n0 * 1024, nullptr, scr, k0, n0, lane); continue; } r -= I_OUT;
            if (r < I_XQ) { const int nblk = 32, k0 = 64 * (r / nblk), n0 = 32 * (r % nblk); p0_transpose_item(w_xq, 1024, 1024, WXQ + (size_t)n0 * 1024, g_xattn, scr, k0, n0, lane); continue; } r -= I_XQ;
            if (r < I_XKV) { const int nblk = 64, k0 = 64 * (r / nblk), n0 = 32 * (r % nblk);
                bf16_t* dst = n0 < 1024 ? WXK + (size_t)n0 * 1024 : WXV + (size_t)(n0 - 1024) * 1024;
                p0_transpose_item(w_xkv, 1024, 2048, dst, nullptr, scr, k0, n0, lane); continue; } r -= I_XKV;
            if (r < I_XO) { const int nblk = 32, k0 = 64 * (r / nblk), n0 = 32 * (r % nblk); p0_transpose_item(w_xo, 1024, 1024, WXO + (size_t)n0 * 1024, nullptr, scr, k0, n0, lane); continue; } r -= I_XO;
            if (r < I_FI) { const int nblk = 176, k0 = 64 * (r / nblk), n0 = 32 * (r % nblk); const int up = n0 >= DFF, j = up ? n0 - DFF : n0;
                p0_transpose_item(w_ffn_in, 1024, 2 * DFF, WFI + (size_t)(256 * (j >> 7) + 128 * up + (j & 127)) * 1024, g_ffn, scr, k0, n0, lane); continue; } r -= I_FI;
            { const int nblk = 32, k0 = 64 * (r / nblk), n0 = 32 * (r % nblk); p0_transpose_item(w_ffn_out, DFF, 1024, WFO + (size_t)n0 * DFF, nullptr, scr, k0, n0, lane); }
        }
        for (int m = gw; m < M + BATCH * NMEM; m += NGW) {
            if (m < M) rms_row_to_bf16(x + (size_t)m * D, g_mix, H1 + (size_t)m * D, lane);
            else rms_row_to_bf16(mem + (size_t)(m - M) * D, g_mem, MEMN + (size_t)(m - M) * D, lane);
        }
        __syncthreads();
    }
    SEAM(0);
    if (IN(1)) {
        { pg8::Gemm g{H1, WMAIN, M, 4608, 1024}; pg8::StaticOrder S; S.init(M, 4608, G, bx);
          pg8::EpiMain E{QA, GA, QB, KB, GATE, LF, lb_table};
          pg8::gemm_phase<pg8::EpiMain, pg8::StaticOrder, true, true>(lds, g, S, E); }
        { pg8::Gemm g{WSWAP, H1, 1024, M, 1024}; pg8::StaticOrder S; S.init(1024, M, G, bx);
          pg8::EpiStore E{VT, M};
          pg8::gemm_phase<pg8::EpiStore, pg8::StaticOrder, true, true>(lds, g, S, E); }
        { pg8::Gemm g{MEMN, WXK, BATCH * NMEM, 1024, 1024}; pg8::StaticOrder S; S.init(BATCH * NMEM, 1024, G, (bx + G - (128 % G)) % G);
          pg8::EpiStore E{MK, 1024};
          pg8::gemm_phase<pg8::EpiStore, pg8::StaticOrder, true, true>(lds, g, S, E); }
        { pg8::Gemm g{WXV, MEMN, 1024, BATCH * NMEM, 1024}; pg8::StaticOrder S; S.init(1024, BATCH * NMEM, G, (bx + G - (136 % G)) % G);
          pg8::EpiStore E{MVT, BATCH * NMEM};
          pg8::gemm_phase<pg8::EpiStore, pg8::StaticOrder, true, true>(lds, g, S, E); }
    }
    SEAM(1);
    if (IN(2)) {
        for (int item = bx; item < 1024; item += G) hgrn_a_item(lds, item, LF, VT, U, GAM);
        for (int wi = bx * NWAVES + wave; wi < 4096; wi += G * NWAVES) sb_wave_item(lds + wave * 4608, wi, QB, KB, VT, YB);
    }
    SEAM(2);
    if (IN(3)) hgrn_scan(U, pr ? (bf16_t*)(dob + 32 * MiB) : U, GAM, G);
    SEAM(3);
    if (IN(4)) { for (int item = bx; item < 1024; item += G) hgrn_e_item(lds, item, LF, QA, GA, VT, U, g_hgrn, YA); }
    SEAM(4);
    if (IN(5)) {
        { pg8::Gemm g{YA, WA, M, 1024, 512}; pg8::StaticOrder S; S.init(M, 1024, G, bx);
          pg8::EpiGate E{GATE, nullptr, T1};
          pg8::gemm_phase<pg8::EpiGate, pg8::StaticOrder, true, true>(lds, g, S, E); }
        { pg8::Gemm g{YB, WB, M, 1024, 512}; pg8::StaticOrder S; S.init(M, 1024, G, bx);
          pg8::EpiGate E{GATE + 1024, T1, MERGED};
          pg8::gemm_phase<pg8::EpiGate, pg8::StaticOrder, true, true>(lds, g, S, E); }
    }
    SEAM(5);
    if (IN(6)) { pg8::Gemm g{MERGED, WOUT, M, 1024, 1024}; pg8::StaticOrder S; S.init(M, 1024, G, bx);
        pg8::EpiResid E{x, pr ? PRO : XR, pr ? PRB : X1B, pr ? PRS : ROWSS1};
        pg8::gemm_phase<pg8::EpiResid, pg8::StaticOrder, true, true>(lds, g, S, E); }
    SEAM(6);
    if (IN(7)) { pg8::Gemm g{X1B, WXQ, M, 1024, 1024}; pg8::StaticOrder S; S.init(M, 1024, G, bx);
        pg8::EpiRowScale E{ROWSS1, XQ, 0.0625f};
        pg8::gemm_phase<pg8::EpiRowScale, pg8::StaticOrder, true, true>(lds, g, S, E); }
    SEAM(7);
    if (IN(8)) { for (int item = bx; item < 256; item += G) { xattn_item(lds, item, XQ, MK, MVT, XO); __syncthreads(); } }
    SEAM(8);
    if (IN(9)) { pg8::Gemm g{XO, WXO, M, 1024, 1024}; pg8::StaticOrder S; S.init(M, 1024, G, bx);
        pg8::EpiResid E{XR, pr ? PRO : XR, pr ? PRB : X2B, pr ? PRS : ROWSS2};
        pg8::gemm_phase<pg8::EpiResid, pg8::StaticOrder, true, true>(lds, g, S, E); }
    SEAM(9);
    if (IN(10)) { pg8::Gemm g{X2B, WFI, M, 2 * DFF, 1024}; pg8::StaticOrder S; S.init(M, 2 * DFF, G, bx);
        pg8::EpiSwiglu E{ROWSS2, FFH};
        pg8::gemm_phase<pg8::EpiSwiglu, pg8::StaticOrder, true, true>(lds, g, S, E); }
    SEAM(10);
    if (IN(11)) { pg8::Gemm g{FFH, WFO, M, 1024, DFF}; pg8::StaticOrder S; S.init(M, 1024, G, bx);
        pg8::EpiResid E{XR, pr ? (float*)(ws + 44 * MiB) : XR, nullptr, pr ? PRS : ROWSS3};
        pg8::gemm_phase<pg8::EpiResid, pg8::StaticOrder, true, true>(lds, g, S, E); }
    SEAM(11);
    if (IN(12)) {
        const int gw = bx * NWAVES + wave, NGW = G * NWAVES;
        for (int m = gw; m < M; m += NGW) {
            const float rstd = rsqrtf(ROWSS3[m] * (1.f / 1024.f) + RMS_EPS);
            f32x4* xr = (f32x4*)(XR + (size_t)m * D) + lane; const f32x4* gr = (const f32x4*)g_final + lane;
#pragma unroll
            for (int j = 0; j < 4; ++j) { f32x4 v = xr[64 * j]; const f32x4 gg = gr[64 * j]; v = v * rstd; v = v * gg; xr[64 * j] = v; }
        }
    }
#ifdef PROBE_SYNCS
    for (int i = 0; i < PROBE_SYNCS; ++i) cg::this_grid().sync();
#endif
#undef IN
#undef SEAM
}

extern "C" void kernel_launch(void* const* d_in, const int* in_sizes, int n_in, void* d_out, int out_size, void* d_ws, size_t ws_size, hipStream_t stream) {
    static int grid = 0;
    if (grid == 0) {
        if (n_in != 19 || out_size != M * D || ws_size < WS_END) { fprintf(stderr, "kernel_launch: unexpected shapes (n_in %d out %d ws %zu)\n", n_in, out_size, ws_size); grid = -1; return; }
        int dev = 0, cus = 0, per_cu = 0;
        hipGetDevice(&dev); hipDeviceGetAttribute(&cus, hipDeviceAttributeMultiprocessorCount, dev);
        hipFuncSetAttribute((const void*)fwd_kernel, hipFuncAttributeMaxDynamicSharedMemorySize, LDS_BYTES);
        hipOccupancyMaxActiveBlocksPerMultiprocessor(&per_cu, (const void*)fwd_kernel, NTHR, LDS_BYTES);
        if (per_cu < 1) { fprintf(stderr, "kernel_launch: occupancy query says %d blocks per CU\n", per_cu); per_cu = 1; }
        (void)hipGetLastError();
        grid = cus * per_cu;
        fprintf(stderr, "kernel_launch: grid %d (cus %d x %d)\n", grid, cus, per_cu);
    }
    if (grid < 0) return;
    hipMemsetAsync((char*)d_ws, 0, CTL_ZERO_BYTES, stream);
    Args a{};
    for (int i = 0; i < 19; ++i) a.in[i] = (const float*)d_in[i];
    a.out = (float*)d_out; a.ws = (unsigned char*)d_ws;
#if MK_ONE_LAUNCH
    a.ph_lo = 0; a.ph_hi = NPHASE;
    void* kargs[] = {&a};
    hipError_t e = hipLaunchCooperativeKernel((const void*)fwd_kernel, dim3(grid), dim3(NTHR), kargs, LDS_BYTES, stream);
    if (e != hipSuccess) fprintf(stderr, "cooperative launch failed: %s (grid %d)\n", hipGetErrorString(e), grid);
#else
    for (int p = 0; p < NPHASE; ++p) { a.ph_lo = p; a.ph_hi = p + 1; hipLaunchKernelGGL(fwd_kernel, dim3(grid), dim3(NTHR), LDS_BYTES, stream, a);
#ifdef PROBE_MASK
        if ((PROBE_MASK >> p) & 1) { a.probe = 1; for (int rr = 0; rr < PROBE_REP; ++rr) hipLaunchKernelGGL(fwd_kernel, dim3(grid), dim3(NTHR), LDS_BYTES, stream, a); a.probe = 0; }
#endif
    }
#endif
}
```

```cpp
#include <hip/hip_runtime.h>
#include <hip/hip_cooperative_groups.h>
#include <cstdio>
#include <cstdint>
namespace cg = cooperative_groups;
namespace pg8 {
#define PG8_LAS __attribute__((address_space(3)))
typedef unsigned short bf16_t;
typedef short bf16x8 __attribute__((ext_vector_type(8)));
typedef float f32x4 __attribute__((ext_vector_type(4)));
typedef unsigned u32x4 __attribute__((ext_vector_type(4)));
constexpr int BM = 256, BK = 64, HALF = 128, HTB = HALF * BK * 2  , STAGE_BYTES = 8 * HTB, NXCD = 8, WGM = 8;

__host__ __device__ __forceinline__ int lds_byte(int r, int c) { const int st = (r >> 4) * 2 + (c >> 5), rr = r & 15, cc = c & 31, ob = rr * 64 + cc * 2; return st * 1024 + (ob ^ (((ob >> 9) & 1) << 5)); }
__host__ __device__ __forceinline__ void stage_rc(int b, int& R, int& C) { const int st = b / 1024, sb = b % 1024, swz = sb ^ (((sb >> 9) & 1) << 5); R = (st >> 1) * 16 + swz / 64; C = (st & 1) * 32 + (swz % 64) / 2; }
__host__ __device__ __forceinline__ int perm32(int rho) { const int n = rho >> 4, i = rho & 15; return 8 * (i >> 2) + 4 * n + (i & 3); }

struct Unit { int pm, pn; };
struct Gemm { const bf16_t* A; const bf16_t* Bt; int M, N, K; };

struct StaticOrder {
    int nM, nN, nwg, G, c;
    __host__ __device__ void init(int M, int N, int G_, int c_) { nM = M / BM; nN = N / BM; nwg = nM * nN; G = G_; c = c_; }
    __host__ __device__ bool next(int i, Unit& u) const {
        const long L = (long)i * G + c; if (L >= nwg) return false;
        int wgid = (int)L; { const int q = nwg / NXCD, r = nwg % NXCD, xcd = wgid % NXCD, off = wgid / NXCD; wgid = (xcd < r ? xcd * (q + 1) : r * (q + 1) + (xcd - r) * q) + off; }
        const int nig = WGM * nN, gid = wgid / nig, fm = gid * WGM, gsz = (nM - fm) < WGM ? (nM - fm) : WGM;
        u.pm = fm + ((wgid % nig) % gsz); u.pn = (wgid % nig) / gsz; return true;
    }
    __device__ __forceinline__ void a_ready(const Unit&) const {}
    __device__ __forceinline__ void done(const Unit&) const {}
};
typedef unsigned u32x2 __attribute__((ext_vector_type(2)));

__device__ __forceinline__ unsigned cvt_pk_bf16(float lo, float hi) { unsigned r; asm volatile("v_cvt_pk_bf16_f32 %0, %1, %2" : "=v"(r) : "v"(lo), "v"(hi)); return r; }
__device__ __forceinline__ float bf2f(unsigned short b) { return __uint_as_float((unsigned)b << 16); }
__device__ __forceinline__ float bflo(unsigned w) { return __uint_as_float(w << 16); }
__device__ __forceinline__ float bfhi(unsigned w) { return __uint_as_float(w & 0xffff0000u); }
__device__ __forceinline__ float fexp(float x) { return __builtin_amdgcn_exp2f(x * 1.4426950408889634f); }
__device__ __forceinline__ float flog(float x) { return __builtin_amdgcn_logf(x) * 0.6931471805599453f; }
__device__ __forceinline__ float fsigmoid(float x) { return __builtin_amdgcn_rcpf(1.f + __builtin_amdgcn_exp2f(x * -1.4426950408889634f)); }
__device__ __forceinline__ float fsilu(float x) { return x * fsigmoid(x); }
constexpr float RMS_EPS = 1e-6f;

struct EpiMain {
    static constexpr bool PERM = true, AFTER_DRAIN = false;
    bf16_t *QA, *GA, *QB, *KB, *GATE; float* LF; const float* lbt;
    __device__ __forceinline__ void operator()(const f32x4 (&acc)[2][2][4][2], const Unit& u, int wr, int wc, int fr, int fq) const {
        const int pn = u.pn; const int row0 = u.pm * BM + wr * 64 + fr; const int cin = wc * 32 + 8 * fq;
        if (pn == 2 || pn == 3) {
#pragma unroll
            for (int bj = 0; bj < 2; ++bj) {
                const int col = (pn - 2) * 256 + bj * HALF + cin;
                float lb[8];
#pragma unroll
                for (int e = 0; e < 8; ++e) { const float t0 = lbt[col + e], t1 = lbt[512 + col + e]; lb[e] = 1.f / (1.f + fexp(t1 - t0)); }
#pragma unroll
                for (int ai = 0; ai < 2; ++ai)
#pragma unroll
                    for (int m = 0; m < 4; ++m) {
                        float* p = LF + (size_t)(row0 + ai * HALF + m * 16) * 512 + col;
                        const f32x4 v0 = acc[ai][bj][m][0], v1 = acc[ai][bj][m][1]; f32x4 o0, o1;
#pragma unroll
                        for (int e = 0; e < 4; ++e) { o0[e] = flog(lb[e] + (1.f - lb[e]) * fsigmoid(v0[e])); o1[e] = flog(lb[4 + e] + (1.f - lb[4 + e]) * fsigmoid(v1[e])); }
                        *(f32x4*)p = o0; *(f32x4*)(p + 4) = o1;
                    }
            }
            return;
        }
        int mode; bf16_t* O; int ldc, colt;
        if (pn < 2) { mode = 1; O = QA; ldc = 512; colt = pn * 256; }
        else if (pn < 6) { mode = 1; O = GA; ldc = 512; colt = (pn - 4) * 256; }
        else if (pn < 8) { mode = 2; O = QB; ldc = 512; colt = (pn - 6) * 256; }
        else if (pn < 10) { mode = 0; O = KB; ldc = 512; colt = (pn - 8) * 256; }
        else { mode = 3; O = GATE; ldc = 2048; colt = (pn - 10) * 256; }
#pragma unroll
        for (int ai = 0; ai < 2; ++ai)
#pragma unroll
            for (int m = 0; m < 4; ++m) { bf16_t* rowp = O + (size_t)(row0 + ai * HALF + m * 16) * ldc + colt + cin;
#pragma unroll
                for (int bj = 0; bj < 2; ++bj) { f32x4 v0 = acc[ai][bj][m][0], v1 = acc[ai][bj][m][1];
                    if (mode == 1) {
#pragma unroll
                        for (int e = 0; e < 4; ++e) { v0[e] = fsilu(v0[e]); v1[e] = fsilu(v1[e]); } }
                    else if (mode == 2) { v0 = v0 * (0.125f * 1.4426950408889634f); v1 = v1 * (0.125f * 1.4426950408889634f); }
                    else if (mode == 3) {
#pragma unroll
                        for (int e = 0; e < 4; ++e) { v0[e] = fsigmoid(v0[e]); v1[e] = fsigmoid(v1[e]); } }
                    u32x4 w; w.x = cvt_pk_bf16(v0[0], v0[1]); w.y = cvt_pk_bf16(v0[2], v0[3]); w.z = cvt_pk_bf16(v1[0], v1[1]); w.w = cvt_pk_bf16(v1[2], v1[3]);
                    *(u32x4*)(rowp + bj * HALF) = w; } }
    }
};
struct EpiStore {
    static constexpr bool PERM = true, AFTER_DRAIN = false;
    bf16_t* O; int ldc;
    __device__ __forceinline__ void operator()(const f32x4 (&acc)[2][2][4][2], const Unit& u, int wr, int wc, int fr, int fq) const {
        const int row0 = u.pm * BM + wr * 64 + fr; const int col0 = u.pn * BM + wc * 32 + 8 * fq;
#pragma unroll
        for (int ai = 0; ai < 2; ++ai)
#pragma unroll
            for (int m = 0; m < 4; ++m) { bf16_t* rowp = O + (size_t)(row0 + ai * HALF + m * 16) * ldc + col0;
#pragma unroll
                for (int bj = 0; bj < 2; ++bj) { const f32x4 v0 = acc[ai][bj][m][0], v1 = acc[ai][bj][m][1];
                    u32x4 w; w.x = cvt_pk_bf16(v0[0], v0[1]); w.y = cvt_pk_bf16(v0[2], v0[3]); w.z = cvt_pk_bf16(v1[0], v1[1]); w.w = cvt_pk_bf16(v1[2], v1[3]);
                    *(u32x4*)(rowp + bj * HALF) = w; } }
    }
};
struct EpiGate {
    static constexpr bool PERM = true, AFTER_DRAIN = false;
    const bf16_t* gate; const bf16_t* addin; bf16_t* out;
    __device__ __forceinline__ void operator()(const f32x4 (&acc)[2][2][4][2], const Unit& u, int wr, int wc, int fr, int fq) const {
        const int row0 = u.pm * BM + wr * 64 + fr; const int col0 = u.pn * BM + wc * 32 + 8 * fq;
#pragma unroll
        for (int ai = 0; ai < 2; ++ai)
#pragma unroll
            for (int m = 0; m < 4; ++m) { const size_t row = (size_t)(row0 + ai * HALF + m * 16);
#pragma unroll
                for (int bj = 0; bj < 2; ++bj) { const f32x4 v0 = acc[ai][bj][m][0], v1 = acc[ai][bj][m][1]; const int col = col0 + bj * HALF;
                    const u32x4 g = *(const u32x4*)(gate + row * 2048 + col);
                    float r[8] = { bflo(g.x) * v0[0], bfhi(g.x) * v0[1], bflo(g.y) * v0[2], bfhi(g.y) * v0[3], bflo(g.z) * v1[0], bfhi(g.z) * v1[1], bflo(g.w) * v1[2], bfhi(g.w) * v1[3] };
                    if (addin) { const u32x4 t = *(const u32x4*)(addin + row * 1024 + col);
                        r[0] += bflo(t.x); r[1] += bfhi(t.x); r[2] += bflo(t.y); r[3] += bfhi(t.y); r[4] += bflo(t.z); r[5] += bfhi(t.z); r[6] += bflo(t.w); r[7] += bfhi(t.w); }
                    u32x4 w; w.x = cvt_pk_bf16(r[0], r[1]); w.y = cvt_pk_bf16(r[2], r[3]); w.z = cvt_pk_bf16(r[4], r[5]); w.w = cvt_pk_bf16(r[6], r[7]);
                    *(u32x4*)(out + row * 1024 + col) = w; } }
    }
};
struct EpiResid {
    static constexpr bool PERM = false, AFTER_DRAIN = false;
    const float* base; float* out; bf16_t* xb; float* rowss;
    __device__ __forceinline__ void operator()(const f32x4 (&acc)[2][2][4][2], const Unit& u, int wr, int wc, int fr, int fq) const {
        const int row0 = u.pm * BM + wr * 64 + fr; const int col0 = u.pn * BM + wc * 32 + 4 * fq;
#pragma unroll
        for (int ai = 0; ai < 2; ++ai)
#pragma unroll
            for (int m = 0; m < 4; ++m) { const size_t row = (size_t)(row0 + ai * HALF + m * 16); float ss = 0.f;
#pragma unroll
                for (int bj = 0; bj < 2; ++bj)
#pragma unroll
                    for (int n = 0; n < 2; ++n) { const size_t off = row * 1024 + col0 + bj * HALF + n * 16;
                        const f32x4 v = *(const f32x4*)(base + off) + acc[ai][bj][m][n];
                        *(f32x4*)(out + off) = v; ss += (v[0] * v[0] + v[1] * v[1]) + (v[2] * v[2] + v[3] * v[3]);
                        if (xb) { u32x2 w; w.x = cvt_pk_bf16(v[0], v[1]); w.y = cvt_pk_bf16(v[2], v[3]); *(u32x2*)(xb + off) = w; } }
                ss += __shfl_xor(ss, 16); ss += __shfl_xor(ss, 32);
                if (fq == 0) unsafeAtomicAdd(rowss + row, ss); }
    }
};
struct EpiRowScale {
    static constexpr bool PERM = true, AFTER_DRAIN = false;
    const float* rowss; bf16_t* out; float scale;
    __device__ __forceinline__ void operator()(const f32x4 (&acc)[2][2][4][2], const Unit& u, int wr, int wc, int fr, int fq) const {
        const int row0 = u.pm * BM + wr * 64 + fr; const int col0 = u.pn * BM + wc * 32 + 8 * fq;
#pragma unroll
        for (int ai = 0; ai < 2; ++ai)
#pragma unroll
            for (int m = 0; m < 4; ++m) { const size_t row = (size_t)(row0 + ai * HALF + m * 16); const float rs = rsqrtf(rowss[row] * (1.f / 1024.f) + RMS_EPS) * scale;
#pragma unroll
                for (int bj = 0; bj < 2; ++bj) { const f32x4 v0 = acc[ai][bj][m][0] * rs, v1 = acc[ai][bj][m][1] * rs;
                    u32x4 w; w.x = cvt_pk_bf16(v0[0], v0[1]); w.y = cvt_pk_bf16(v0[2], v0[3]); w.z = cvt_pk_bf16(v1[0], v1[1]); w.w = cvt_pk_bf16(v1[2], v1[3]);
                    *(u32x4*)(out + row * 1024 + col0 + bj * HALF) = w; } }
    }
};
struct EpiSwiglu {
    static constexpr bool PERM = true, AFTER_DRAIN = false;
    const float* rowss; bf16_t* out;
    __device__ __forceinline__ void operator()(const f32x4 (&acc)[2][2][4][2], const Unit& u, int wr, int wc, int fr, int fq) const {
        const int row0 = u.pm * BM + wr * 64 + fr; const int col0 = u.pn * HALF + wc * 32 + 8 * fq;
#pragma unroll
        for (int ai = 0; ai < 2; ++ai)
#pragma unroll
            for (int m = 0; m < 4; ++m) { const size_t row = (size_t)(row0 + ai * HALF + m * 16); const float rs = rsqrtf(rowss[row] * (1.f / 1024.f) + RMS_EPS);
                float r[8];
#pragma unroll
                for (int n = 0; n < 2; ++n)
#pragma unroll
                    for (int e = 0; e < 4; ++e) r[4 * n + e] = fsilu(acc[ai][0][m][n][e] * rs) * (acc[ai][1][m][n][e] * rs);
                u32x4 w; w.x = cvt_pk_bf16(r[0], r[1]); w.y = cvt_pk_bf16(r[2], r[3]); w.z = cvt_pk_bf16(r[4], r[5]); w.w = cvt_pk_bf16(r[6], r[7]);
                *(u32x4*)(out + row * 2816 + col0) = w; }
    }
};

template <class Epi, class Sched, bool ALIGN_EPI = false, bool SP2 = false>
__device__ __forceinline__ void gemm_phase(PG8_LAS unsigned char* lds, const Gemm g, const Sched& S, const Epi& E) {
    const int tid = threadIdx.x, wid = __builtin_amdgcn_readfirstlane(tid >> 6), lane = tid & 63, wr = wid >> 2, wc = wid & 3, fr = lane & 15, fq = lane >> 4;
    const int K = g.K, nt = K / BK;
    unsigned voffA[2], voffB[2];
#pragma unroll
    for (int i = 0; i < 2; ++i) { int R, C; stage_rc(tid * 16 + i * 8192, R, C); const int Rb = Epi::PERM ? ((R & ~31) + perm32(R & 31)) : R;
        voffA[i] = (unsigned)(R * K + C) * 2u; voffB[i] = (unsigned)(Rb * K + C) * 2u; }
    const size_t kstep = (size_t)(BK * 2);
    const size_t hstep = (size_t)HALF * K * 2;
    const size_t tstep = 2 * hstep;
    const unsigned ldsw = (unsigned)wid * 1024u;
    const int aoff = lds_byte(wr * 64 + fr, fq * 8), boff = lds_byte(wc * 32 + fr, fq * 8);
#define PG8_SA(b, h) (((b) * 2 + (h)) * HTB)
#define PG8_SB(b, h) ((4 + (b) * 2 + (h)) * HTB)
#define PG8_STAGE(bufoff, gbase, voff) do { _Pragma("unroll") for (int _i = 0; _i < 2; ++_i) \
        __builtin_amdgcn_global_load_lds((const unsigned*)((const char*)(gbase) + (voff)[_i]), (PG8_LAS unsigned*)(lds + (bufoff) + ldsw + _i * 8192), 16, 0, 0); } while (0)
#define PG8_LDA(dst, b, h) do { _Pragma("unroll") for (int m = 0; m < 4; ++m) _Pragma("unroll") for (int k = 0; k < 2; ++k) dst[m][k] = *(const PG8_LAS bf16x8*)(lds + PG8_SA(b, h) + aoff + m * 2048 + k * 1024); } while (0)
#define PG8_LDB(dst, b, h) do { _Pragma("unroll") for (int n = 0; n < 2; ++n) _Pragma("unroll") for (int k = 0; k < 2; ++k) dst[n][k] = *(const PG8_LAS bf16x8*)(lds + PG8_SB(b, h) + boff + n * 2048 + k * 1024); } while (0)
#define PG8_MMA(ai, bj, At, Bt) do { __builtin_amdgcn_s_setprio(1); _Pragma("unroll") for (int m = 0; m < 4; ++m) _Pragma("unroll") for (int n = 0; n < 2; ++n) _Pragma("unroll") for (int k = 0; k < 2; ++k) \
        acc[ai][bj][m][n] = __builtin_amdgcn_mfma_f32_16x16x32_bf16(Bt[n][k], At[m][k], acc[ai][bj][m][n], 0, 0, 0); __builtin_amdgcn_s_setprio(0); } while (0)
#define PG8_WAIT_V(n) asm volatile("s_waitcnt vmcnt(" #n ")" ::: "memory")
#define PG8_WAIT_L(n) asm volatile("s_waitcnt lgkmcnt(" #n ")" ::: "memory")
#define PG8_BAR __builtin_amdgcn_s_barrier()
#define PG8_SCHED __builtin_amdgcn_sched_barrier(0)
    Unit cur, nxt; int ui = 0;
    if (!S.next(0, cur)) return;
    f32x4 acc[2][2][4][2];
#pragma unroll
    for (int a = 0; a < 2; ++a)
#pragma unroll
        for (int b = 0; b < 2; ++b)
#pragma unroll
            for (int m = 0; m < 4; ++m)
#pragma unroll
                for (int n = 0; n < 2; ++n) acc[a][b][m][n] = (f32x4){0.f, 0.f, 0.f, 0.f};
    bf16x8 At[4][2], B0[2][2], B1[2][2];
    const char* cA = (const char*)g.A + (size_t)cur.pm * tstep; const char* cB = (const char*)g.Bt + (size_t)cur.pn * tstep;
    S.a_ready(cur);
    if constexpr (SP2) {
        PG8_STAGE(PG8_SB(0, 0), cB, voffB); PG8_STAGE(PG8_SB(0, 1), cB + hstep, voffB); PG8_STAGE(PG8_SA(0, 0), cA, voffA); PG8_STAGE(PG8_SA(0, 1), cA + hstep, voffA);
        if (wr == 1) PG8_BAR;
        PG8_WAIT_V(2); PG8_BAR;
        PG8_STAGE(PG8_SB(1, 0), cB + kstep, voffB); PG8_STAGE(PG8_SA(1, 0), cA + kstep, voffA); PG8_STAGE(PG8_SB(1, 1), cB + hstep + kstep, voffB);
        PG8_WAIT_V(6); PG8_BAR;
    } else {
        PG8_STAGE(PG8_SB(0, 0), cB, voffB); PG8_STAGE(PG8_SA(0, 0), cA, voffA); PG8_STAGE(PG8_SB(0, 1), cB + hstep, voffB); PG8_STAGE(PG8_SA(0, 1), cA + hstep, voffA);
        if (wr == 1) PG8_BAR;
        PG8_WAIT_V(4); PG8_BAR;
        PG8_STAGE(PG8_SB(1, 0), cB + kstep, voffB); PG8_STAGE(PG8_SA(1, 0), cA + kstep, voffA); PG8_STAGE(PG8_SB(1, 1), cB + hstep + kstep, voffB);
        PG8_WAIT_V(6); PG8_BAR;
    }
    for (;;) {
        const bool has_next = S.next(ui + 1, nxt);
        const char* nA = has_next ? (const char*)g.A + (size_t)nxt.pm * tstep : cA; const char* nB = has_next ? (const char*)g.Bt + (size_t)nxt.pn * tstep : cB;
        for (int t = 0; t < nt; t += 2) {
            const bool last = (t == nt - 2);
            const char* a1 = cA + (size_t)(t + 1) * kstep;
            const char* a2 = last ? nA : cA + (size_t)(t + 2) * kstep; const char* b2 = last ? nB : cB + (size_t)(t + 2) * kstep;
            const char* a3 = a2 + kstep; const char* b3 = b2 + kstep;
            if (last && has_next) S.a_ready(nxt);
            if constexpr (SP2) {
            PG8_LDB(B0, 0, 0); PG8_LDB(B1, 0, 1); PG8_SCHED; PG8_LDA(At, 0, 0); PG8_STAGE(PG8_SA(1, 1), a1 + hstep, voffA);
            PG8_WAIT_V(8); PG8_WAIT_L(0); PG8_BAR; PG8_MMA(0, 0, At, B0); PG8_MMA(0, 1, At, B1); PG8_BAR; PG8_SCHED;
            PG8_LDA(At, 0, 1); PG8_STAGE(PG8_SB(0, 0), b2, voffB); PG8_STAGE(PG8_SB(0, 1), b2 + hstep, voffB); PG8_STAGE(PG8_SA(0, 0), a2, voffA);
            PG8_WAIT_V(8); PG8_WAIT_L(0); PG8_BAR; PG8_MMA(1, 0, At, B0); PG8_MMA(1, 1, At, B1); PG8_BAR; PG8_SCHED;
            PG8_LDB(B0, 1, 0); PG8_LDB(B1, 1, 1); PG8_SCHED; PG8_LDA(At, 1, 0); PG8_STAGE(PG8_SA(0, 1), a2 + hstep, voffA);
            PG8_WAIT_V(8); PG8_WAIT_L(0); PG8_BAR; PG8_MMA(0, 0, At, B0); PG8_MMA(0, 1, At, B1); PG8_BAR; PG8_SCHED;
            PG8_LDA(At, 1, 1); PG8_STAGE(PG8_SB(1, 0), b3, voffB); PG8_STAGE(PG8_SB(1, 1), b3 + hstep, voffB); PG8_STAGE(PG8_SA(1, 0), a3, voffA);
            PG8_WAIT_V(8); PG8_WAIT_L(0); PG8_BAR; PG8_MMA(1, 0, At, B0); PG8_MMA(1, 1, At, B1); PG8_BAR; PG8_SCHED;
            } else {
            PG8_LDB(B0, 0, 0); PG8_SCHED; PG8_LDA(At, 0, 0); PG8_STAGE(PG8_SA(1, 1), a1 + hstep, voffA);
            PG8_WAIT_L(8); PG8_BAR; PG8_WAIT_L(0); PG8_MMA(0, 0, At, B0); PG8_BAR; PG8_SCHED;
            PG8_LDB(B1, 0, 1); PG8_STAGE(PG8_SB(0, 0), b2, voffB);
            PG8_BAR; PG8_WAIT_L(0); PG8_MMA(0, 1, At, B1); PG8_BAR;
            PG8_LDA(At, 0, 1); PG8_STAGE(PG8_SA(0, 0), a2, voffA);
            PG8_BAR; PG8_WAIT_L(0); PG8_MMA(1, 0, At, B0); PG8_BAR; PG8_SCHED;
            PG8_STAGE(PG8_SB(0, 1), b2 + hstep, voffB);
            PG8_WAIT_V(6); PG8_BAR; PG8_MMA(1, 1, At, B1); PG8_BAR;
            PG8_LDB(B0, 1, 0); PG8_SCHED; PG8_LDA(At, 1, 0); PG8_STAGE(PG8_SA(0, 1), a2 + hstep, voffA);
            PG8_WAIT_L(8); PG8_BAR; PG8_WAIT_L(0); PG8_MMA(0, 0, At, B0); PG8_BAR; PG8_SCHED;
            PG8_LDB(B1, 1, 1); PG8_STAGE(PG8_SB(1, 0), b3, voffB);
            PG8_BAR; PG8_WAIT_L(0); PG8_MMA(0, 1, At, B1); PG8_BAR;
            PG8_LDA(At, 1, 1); PG8_STAGE(PG8_SA(1, 0), a3, voffA);
            PG8_BAR; PG8_WAIT_L(0); PG8_MMA(1, 0, At, B0); PG8_BAR; PG8_SCHED;
            PG8_STAGE(PG8_SB(1, 1), b3 + hstep, voffB);
            PG8_WAIT_V(6); PG8_BAR; PG8_MMA(1, 1, At, B1); PG8_BAR;
            }
        }
        if constexpr (ALIGN_EPI) { if (wr == 0) PG8_BAR; }
        if constexpr (!Epi::AFTER_DRAIN) { E(acc, cur, wr, wc, fr, fq); S.done(cur); }
        if (!has_next) break;
#pragma unroll
        for (int a = 0; a < 2; ++a)
#pragma unroll
            for (int b = 0; b < 2; ++b)
#pragma unroll
                for (int m = 0; m < 4; ++m)
#pragma unroll
                    for (int n = 0; n < 2; ++n) acc[a][b][m][n] = (f32x4){0.f, 0.f, 0.f, 0.f};
        cur = nxt; cA = nA; cB = nB; ++ui;
        if constexpr (ALIGN_EPI) { if (wr == 1) PG8_BAR; }
    }
    PG8_WAIT_V(0);
    if constexpr (!ALIGN_EPI) { if (wr == 0) PG8_BAR; }
    PG8_BAR;
    if constexpr (Epi::AFTER_DRAIN) { E.fused(acc, cur, wr, wc, fr, fq, lds, wid, lane); S.done(cur); }
#undef PG8_SA
#undef PG8_SB
#undef PG8_STAGE
#undef PG8_LDA
#undef PG8_LDB
#undef PG8_MMA
#undef PG8_WAIT_V
#undef PG8_WAIT_L
#undef PG8_BAR
#undef PG8_SCHED
}
}
#define LAS __attribute__((address_space(3)))
using pg8::bf16_t; using pg8::cvt_pk_bf16; using pg8::bf2f; using pg8::bflo; using pg8::bfhi; using pg8::fsigmoid; using pg8::fexp; using pg8::flog; using pg8::fsilu; using pg8::RMS_EPS;
typedef short bf16x8 __attribute__((ext_vector_type(8)));
typedef short s16x4 __attribute__((ext_vector_type(4)));
typedef float f32x4 __attribute__((ext_vector_type(4)));
typedef float f32x16 __attribute__((ext_vector_type(16)));
typedef unsigned u32x4 __attribute__((ext_vector_type(4)));
typedef unsigned u32x2 __attribute__((ext_vector_type(2)));
#define MFMA32(a, b, c) __builtin_amdgcn_mfma_f32_32x32x16_bf16((a), (b), (c), 0, 0, 0)
#define MFMA16(a, b, c) __builtin_amdgcn_mfma_f32_16x16x32_bf16((a), (b), (c), 0, 0, 0)
#define DI __device__ __forceinline__
DI int crow(int reg, int h) { return (reg & 3) + 8 * (reg >> 2) + 4 * h; }
DI unsigned short f2bf(float f) { unsigned u = __float_as_uint(f); return (unsigned short)((u + 0x7fffu + ((u >> 16) & 1u)) >> 16); }
DI unsigned pk2(float lo, float hi) { return (unsigned)f2bf(lo) | ((unsigned)f2bf(hi) << 16); }
#define LDS_WAIT() asm volatile("s_waitcnt lgkmcnt(0)" ::: "memory")
#define BARL() do { asm volatile("s_waitcnt lgkmcnt(0)" ::: "memory"); __builtin_amdgcn_s_barrier(); asm volatile("" ::: "memory"); } while (0)

#define RLX_AGENT __ATOMIC_RELAXED, __HIP_MEMORY_SCOPE_AGENT
#define XB_TMO      128
#define XB_XCNT(j)  (256  + 64 * (j))
#define XB_XSUB(j)  (1280 + 64 * (j))
#define XB_XGEN(j)  (2304 + 64 * (j))
#define XB_TOP      3328
#define XB_TOPGEN   3392
#define XCD_BAR_WORDS 3456
#define XB_SPIN_CAP (1u << 18)

__device__ __forceinline__ unsigned xb_ld(unsigned* p)              { return __hip_atomic_load(p, __ATOMIC_RELAXED, __HIP_MEMORY_SCOPE_AGENT); }
__device__ __forceinline__ unsigned xb_add(unsigned* p, unsigned v) { return __hip_atomic_fetch_add(p, v, __ATOMIC_RELAXED, __HIP_MEMORY_SCOPE_AGENT); }
__device__ __forceinline__ unsigned xb_xcc_id() { return (unsigned)__builtin_amdgcn_s_getreg((3 << 11) | 20) & 0xFu; }
#define XB_SPIN(cond, bar) do { unsigned _sp = 0; while (cond) { __builtin_amdgcn_s_sleep(1); \
    if ((++_sp & 255u) == 0u) { if (xb_ld(&(bar)[XB_TMO])) break; if (_sp > XB_SPIN_CAP) { atomicAdd(&(bar)[XB_TMO], 1u); break; } } } } while (0)

struct XcdBarrier {
    unsigned* bar; unsigned x;
    volatile LAS unsigned* st;
};

__device__ __forceinline__ XcdBarrier xcd_barrier_post(unsigned* bar, volatile LAS unsigned* st) {
    XcdBarrier b; b.bar = bar; b.x = xb_xcc_id(); b.st = st;
    if (threadIdx.x == 0) (void)xb_add(&bar[XB_XCNT(b.x)], 1u);
    return b;
}
__device__ __forceinline__ void xcd_barrier_complete(unsigned* bar, unsigned x, unsigned& nloc, unsigned& nx) {
    const unsigned G = gridDim.x * gridDim.y * gridDim.z;
    unsigned sum, cnt, mine, sp = 0u;
    for (;;) {
        sum = 0u; cnt = 0u; mine = 0u;
#pragma unroll
        for (unsigned j = 0; j < 16; ++j) { const unsigned c = xb_ld(&bar[XB_XCNT(j)]); sum += c; cnt += (c > 0u) ? 1u : 0u; mine = (j == x) ? c : mine; }
        if (sum == G) break;
        __builtin_amdgcn_s_sleep(1);
        if ((++sp & 255u) == 0u) { if (xb_ld(&bar[XB_TMO])) break; if (sp > XB_SPIN_CAP) { atomicAdd(&bar[XB_TMO], 1u); break; } }
    }
    nloc = mine > 0u ? mine : 1u; nx = cnt > 0u ? cnt : 1u;
}

__device__ __forceinline__ void xcd_barrier(const XcdBarrier& b) {
    asm volatile("s_waitcnt vmcnt(0)" ::: "memory");
    __syncthreads();
    if (threadIdx.x == 0) {
        unsigned* bar = b.bar;
        __builtin_amdgcn_s_waitcnt(0);
        unsigned nloc = b.st[0], nx = b.st[1];
        if (nloc == 0u) { xcd_barrier_complete(bar, b.x, nloc, nx); b.st[0] = nloc; b.st[1] = nx; }
        const unsigned old = xb_add(&bar[XB_XSUB(b.x)], 1u);
        const unsigned gen = old / nloc;
        if (old + 1u == (gen + 1u) * nloc) {
            __builtin_amdgcn_fence(__ATOMIC_RELEASE, "agent");
            asm volatile("s_waitcnt vmcnt(0)" ::: "memory");
            const unsigned og = xb_add(&bar[XB_TOP], 1u);
            const unsigned tg = og / nx;
            if (og + 1u == (tg + 1u) * nx) xb_add(&bar[XB_TOPGEN], 1u);
            else XB_SPIN(xb_ld(&bar[XB_TOPGEN]) == tg, bar);
            __builtin_amdgcn_fence(__ATOMIC_ACQUIRE, "agent");
            xb_add(&bar[XB_XGEN(b.x)], 1u);
            asm volatile("s_waitcnt vmcnt(0)" ::: "memory");
        } else {
            XB_SPIN(xb_ld(&bar[XB_XGEN(b.x)]) == gen, bar);
            __builtin_amdgcn_fence(__ATOMIC_ACQUIRE, "agent");
            asm volatile("s_waitcnt vmcnt(0)" ::: "memory");
        }
    }
    __syncthreads();
}

constexpr int NWAVES = 8, NTHR = 512;
constexpr int BATCH = 2, T = 8192, D = 1024, M = BATCH * T, NMEM = 256, DFF = 2816;
constexpr size_t MiB = 1u << 20;
constexpr size_t WS_BAR = 212992;
constexpr size_t WS_ROWSS1 = 0, WS_ROWSS2 = 65536, WS_ROWSS3 = 131072, CTL_ZERO_BYTES = 262144;
constexpr size_t WS_MEMN = 1 * MiB, WS_MK = 2 * MiB, WS_MVT = 3 * MiB;
constexpr size_t WS_WMAIN = 4 * MiB, WS_WSWAP = 13 * MiB, WS_WA = 15 * MiB, WS_WB = 16 * MiB, WS_WOUT = 17 * MiB, WS_WXQ = 19 * MiB, WS_WXK = 21 * MiB, WS_WXV = 23 * MiB,
                 WS_WXO = 25 * MiB, WS_WFI = 27 * MiB, WS_WFO = 38 * MiB;
constexpr size_t WS_QA = 44 * MiB, WS_GA = 60 * MiB, WS_LF = 76 * MiB, WS_VT = 108 * MiB, WS_GATE = 140 * MiB, WS_U = 204 * MiB, WS_YA = 236 * MiB, WS_GAM = 252 * MiB;
constexpr size_t WS_T1 = 44 * MiB, WS_MERGED = 76 * MiB, WS_X1B = 108 * MiB, WS_XQ = 44 * MiB, WS_XO = 76 * MiB, WS_X2B = 108 * MiB, WS_FFH = 140 * MiB;
constexpr size_t WS_END = 256 * MiB;
constexpr size_t DO_H1 = 0, DO_QB = 32 * MiB, DO_KB = 48 * MiB, DO_YB = 0;
constexpr int LDS_BYTES = 147456;

DI float wave_sum(float v) {
#pragma unroll
    for (int o = 1; o < 64; o <<= 1) v += __shfl_xor(v, o);
    return v;
}
DI void p0_transpose_item(const float* W, int K, int N, bf16_t* dst, const float* gk, LAS float* scr, int k0, int n0, int lane) {
#pragma unroll 8
    for (int i = 0; i < 32; ++i) { const int kk = 2 * i + (lane >> 5); float w = W[(size_t)(k0 + kk) * N + n0 + (lane & 31)]; if (gk) w *= gk[k0 + kk]; scr[kk * 33 + (lane & 31)] = w; }
    LDS_WAIT();
    const int c = lane & 7;
#pragma unroll
    for (int j = 0; j < 4; ++j) { const int n = (lane >> 3) + 8 * j; const LAS float* s = scr + (8 * c) * 33 + n;
        u32x4 o; o.x = pk2(s[0 * 33], s[1 * 33]); o.y = pk2(s[2 * 33], s[3 * 33]); o.z = pk2(s[4 * 33], s[5 * 33]); o.w = pk2(s[6 * 33], s[7 * 33]);
        *(u32x4*)(dst + (size_t)n * K + k0 + 8 * c) = o; }
    LDS_WAIT();
}
DI void rms_row_to_bf16(const float* xrow, const float* g, bf16_t* orow, int lane) {
    const f32x4* xr = (const f32x4*)xrow + lane; const f32x4* gr = (const f32x4*)g + lane;
    f32x4 v[4]; float s = 0.f;
#pragma unroll
    for (int j = 0; j < 4; ++j) { v[j] = xr[64 * j]; s += (v[j].x * v[j].x + v[j].y * v[j].y) + (v[j].z * v[j].z + v[j].w * v[j].w); }
    const float rstd = rsqrtf(wave_sum(s) * (1.f / 1024.f) + RMS_EPS);
    unsigned long long* o8 = (unsigned long long*)orow + lane;
#pragma unroll
    for (int j = 0; j < 4; ++j) { const f32x4 gg = gr[64 * j];
        o8[64 * j] = (unsigned long long)pk2(v[j].x * rstd * gg.x, v[j].y * rstd * gg.y) | ((unsigned long long)pk2(v[j].z * rstd * gg.z, v[j].w * rstd * gg.w) << 32); }
}

DI void hgrn_a_item(LAS unsigned char* lds, int item, const float* LF, const bf16_t* VT, bf16_t* U, float* GAM) {
    const int tid = threadIdx.x, lane = tid & 63, wave = tid >> 6;
    const int bh = item >> 7, c = item & 127, b = bh >> 2, h = bh & 3;
    const size_t row0 = (size_t)b * T + c * 64;
    LAS float* PT = (LAS float*)(lds + 32768);
    LAS bf16_t* KT = (LAS bf16_t*)(lds + 34816);
    const int d = tid & 127, part = tid >> 7;
    float lf[16], bb[16];
#pragma unroll
    for (int j = 0; j < 16; ++j) lf[j] = LF[(row0 + part * 16 + j) * 512 + h * 128 + d];
    const int r = lane & 31, hh = lane >> 5, mt = wave >> 1, ntb = (wave & 1) * 2;
    bf16x8 vfr[4];
    { const bf16_t* vrow = VT + (size_t)(h * 128 + mt * 32 + r) * M + row0 + 8 * hh;
#pragma unroll
      for (int s = 0; s < 4; ++s) vfr[s] = *(const bf16x8*)(vrow + 16 * s); }
    float run = 0.f;
#pragma unroll
    for (int j = 0; j < 16; ++j) { run += lf[j]; bb[j] = run; }
    PT[part * 128 + d] = run;
    BARL();
    float off = 0.f, tot = 0.f;
#pragma unroll
    for (int p = 0; p < 4; ++p) { const float v = PT[p * 128 + d]; if (p < part) off += v; tot += v; }
    unsigned pk[8];
#pragma unroll
    for (int j = 0; j < 16; j += 2) { const float k0 = (1.f - fexp(lf[j])) * fexp(tot - (bb[j] + off)), k1 = (1.f - fexp(lf[j + 1])) * fexp(tot - (bb[j + 1] + off)); pk[j >> 1] = cvt_pk_bf16(k0, k1); }
    LAS u32x4* dst = (LAS u32x4*)(KT + d * 72 + part * 16);
    dst[0] = (u32x4){pk[0], pk[1], pk[2], pk[3]}; dst[1] = (u32x4){pk[4], pk[5], pk[6], pk[7]};
    if (part == 0) GAM[(size_t)item * 128 + d] = fexp(tot);
    BARL();
    f32x16 acc0, acc1;
#pragma unroll
    for (int i = 0; i < 16; ++i) { acc0[i] = 0.f; acc1[i] = 0.f; }
#pragma unroll
    for (int s = 0; s < 4; ++s) { const bf16x8 a = vfr[s];
        const bf16x8 b0 = *(const LAS bf16x8*)(KT + (ntb * 32 + r) * 72 + 16 * s + 8 * hh), b1 = *(const LAS bf16x8*)(KT + ((ntb + 1) * 32 + r) * 72 + 16 * s + 8 * hh);
        acc0 = MFMA32(a, b0, acc0); acc1 = MFMA32(a, b1, acc1); }
    bf16_t* up = U + (size_t)item * 16384;
#pragma unroll
    for (int i = 0; i < 16; ++i) { const int v = mt * 32 + crow(i, hh); up[v * 128 + ntb * 32 + r] = f2bf(acc0[i]); up[v * 128 + (ntb + 1) * 32 + r] = f2bf(acc1[i]); }
    BARL();
}
DI void hgrn_scan(bf16_t* U, bf16_t* SD, const float* GAM, int G) {
    const int tid = threadIdx.x;
    if (tid >= 256) return;
    for (int e = blockIdx.x * 256 + tid; e < 65536; e += G * 256) {
        const int bh = e >> 13, rem = e & 8191;
        float s0 = 0.f, s1 = 0.f;
        unsigned* up = (unsigned*)(U + (size_t)bh * 128 * 16384) + rem; unsigned* sp = (unsigned*)(SD + (size_t)bh * 128 * 16384) + rem;
        const float* gp = GAM + (size_t)bh * 128 * 128 + ((rem * 2) & 127);
        for (int c0 = 0; c0 < 128; c0 += 8) {
            unsigned uu[8]; float g0[8], g1[8];
#pragma unroll
            for (int j = 0; j < 8; ++j) { uu[j] = up[(size_t)(c0 + j) * 8192]; g0[j] = gp[(c0 + j) * 128]; g1[j] = gp[(c0 + j) * 128 + 1]; }
#pragma unroll
            for (int j = 0; j < 8; ++j) { sp[(size_t)(c0 + j) * 8192] = pk2(s0, s1); s0 = g0[j] * s0 + bflo(uu[j]); s1 = g1[j] * s1 + bfhi(uu[j]); }
        }
    }
}
DI void hgrn_e_item(LAS unsigned char* lds, int item, const float* LF, const bf16_t* QA, const bf16_t* GA, const bf16_t* VT, const bf16_t* SST, const float* g_hgrn, bf16_t* YA) {
    const int tid = threadIdx.x, lane = tid & 63, wave = tid >> 6;
    const int bh = item >> 7, c = item & 127, b = bh >> 2, h = bh & 3;
    const size_t row0 = (size_t)b * T + c * 64;
    LAS float* PT = (LAS float*)(lds + 32768);
    LAS bf16_t* QT = (LAS bf16_t*)(lds + 34816);
    LAS bf16_t* QD = (LAS bf16_t*)(lds + 52224);
    LAS bf16_t* KD = (LAS bf16_t*)(lds + 69632);
    LAS bf16_t* SC = (LAS bf16_t*)(lds + 113152);
    LAS float* SSQ = (LAS float*)(lds + 122368);
    const int d = tid & 127, part = tid >> 7;
    float lf[16], bb[16];
#pragma unroll
    for (int j = 0; j < 16; ++j) lf[j] = LF[(row0 + part * 16 + j) * 512 + h * 128 + d];
    const int mt = wave >> 2, nt = wave & 3, r = lane & 31, hh = lane >> 5;
    u32x4 qraw2[2];
#pragma unroll
    for (int w = 0; w < 2; ++w) { const int wi = tid + NTHR * w; qraw2[w] = *(const u32x4*)(QA + (row0 + (wi >> 4)) * 512 + h * 128 + 8 * (wi & 15)); }
    bf16x8 sfr[8], vfr[4];
    { const bf16_t* sst = SST + (size_t)item * 16384 + (32 * nt + r) * 128 + 8 * hh;
#pragma unroll
      for (int s = 0; s < 8; ++s) sfr[s] = *(const bf16x8*)(sst + 16 * s);
      const bf16_t* vt = VT + (size_t)(h * 128 + 32 * nt + r) * M + row0 + 8 * hh;
#pragma unroll
      for (int s = 0; s < 4; ++s) vfr[s] = *(const bf16x8*)(vt + 16 * s); }
    unsigned short gav[16];
#pragma unroll
    for (int i = 0; i < 16; ++i) gav[i] = GA[(row0 + 32 * mt + crow(i, hh)) * 512 + h * 128 + 32 * nt + r];
    const float gh = g_hgrn[h * 128 + 32 * nt + r];
    float run = 0.f;
#pragma unroll
    for (int j = 0; j < 16; ++j) { run += lf[j]; bb[j] = run; }
    PT[part * 128 + d] = run;
    for (int u = tid; u < 2304; u += NTHR) ((LAS unsigned*)SC)[u] = 0u;
    LAS float* Bf = (LAS float*)lds;
#pragma unroll
    for (int j = 0; j < 16; ++j) Bf[(part * 16 + j) * 128 + d] = bb[j];
    BARL();
#pragma unroll
    for (int w = 0; w < 2; ++w) {
        const int wi = tid + NTHR * w, t = wi >> 4, dg = wi & 15, pt = t >> 4, d0 = 8 * dg;
        float bbv[8], lfv[8], B1v[8], B2v[8], B3v[8];
        { const f32x4 a0 = *(const LAS f32x4*)(Bf + t * 128 + d0), a1 = *(const LAS f32x4*)(Bf + t * 128 + d0 + 4);
#pragma unroll
          for (int e = 0; e < 4; ++e) { bbv[e] = a0[e]; bbv[4 + e] = a1[e]; } }
        if (t & 15) { const f32x4 a0 = *(const LAS f32x4*)(Bf + (t - 1) * 128 + d0), a1 = *(const LAS f32x4*)(Bf + (t - 1) * 128 + d0 + 4);
#pragma unroll
          for (int e = 0; e < 4; ++e) { lfv[e] = bbv[e] - a0[e]; lfv[4 + e] = bbv[4 + e] - a1[e]; } }
        else {
#pragma unroll
          for (int e = 0; e < 8; ++e) lfv[e] = bbv[e]; }
        { const f32x4 p0 = *(const LAS f32x4*)(PT + d0), p1 = *(const LAS f32x4*)(PT + d0 + 4), q0 = *(const LAS f32x4*)(PT + 128 + d0), q1 = *(const LAS f32x4*)(PT + 128 + d0 + 4),
                      r0 = *(const LAS f32x4*)(PT + 256 + d0), r1 = *(const LAS f32x4*)(PT + 256 + d0 + 4);
#pragma unroll
          for (int e = 0; e < 4; ++e) { B1v[e] = p0[e]; B1v[4 + e] = p1[e]; B2v[e] = p0[e] + q0[e]; B2v[4 + e] = p1[e] + q1[e]; B3v[e] = B2v[e] + r0[e]; B3v[4 + e] = B2v[4 + e] + r1[e]; } }
        const u32x4 qraw = qraw2[w];
        const float qv[8] = { bflo(qraw.x), bfhi(qraw.x), bflo(qraw.y), bfhi(qraw.y), bflo(qraw.z), bfhi(qraw.z), bflo(qraw.w), bfhi(qraw.w) };
        float o1[8], o2[8], kv[8], btv[8];
#pragma unroll
        for (int e = 0; e < 8; ++e) { const float off = pt == 0 ? 0.f : (pt == 1 ? B1v[e] : (pt == 2 ? B2v[e] : B3v[e])); btv[e] = bbv[e] + off;
            o1[e] = qv[e] * fexp(btv[e]); o2[e] = qv[e] * fexp(bbv[e]); kv[e] = 1.f - fexp(lfv[e]); }
        *(LAS u32x4*)(QT + t * 136 + d0) = (u32x4){cvt_pk_bf16(o1[0], o1[1]), cvt_pk_bf16(o1[2], o1[3]), cvt_pk_bf16(o1[4], o1[5]), cvt_pk_bf16(o1[6], o1[7])};
        *(LAS u32x4*)(QD + t * 136 + d0) = (u32x4){cvt_pk_bf16(o2[0], o2[1]), cvt_pk_bf16(o2[2], o2[3]), cvt_pk_bf16(o2[4], o2[5]), cvt_pk_bf16(o2[6], o2[7])};
#pragma unroll
        for (int ip = 0; ip < 4; ++ip) if (ip >= pt) {
            float kd[8];
#pragma unroll
            for (int e = 0; e < 8; ++e) { const float beta = ip == 0 ? 0.f : (ip == 1 ? B1v[e] : (ip == 2 ? B2v[e] : B3v[e])); kd[e] = kv[e] * fexp(beta - btv[e]); }
            *(LAS u32x4*)(KD + (8 * ip * (ip + 1) + t) * 136 + d0) = (u32x4){cvt_pk_bf16(kd[0], kd[1]), cvt_pk_bf16(kd[2], kd[3]), cvt_pk_bf16(kd[4], kd[5]), cvt_pk_bf16(kd[6], kd[7])};
        }
    }
    BARL();
    for (int tile = wave; tile < 10; tile += 8) {
        const int i = tile >= 6 ? 3 : (tile >= 3 ? 2 : (tile >= 1 ? 1 : 0)), j = tile - (i * (i + 1)) / 2, base = 8 * i * (i + 1);
        const int r16 = lane & 15, q4 = lane >> 4;
        f32x4 sc = {0.f, 0.f, 0.f, 0.f};
#pragma unroll
        for (int s = 0; s < 4; ++s) { const bf16x8 a = *(const LAS bf16x8*)(QD + (16 * i + r16) * 136 + 32 * s + 8 * q4), bq = *(const LAS bf16x8*)(KD + (base + 16 * j + r16) * 136 + 32 * s + 8 * q4);
            sc = MFMA16(a, bq, sc); }
#pragma unroll
        for (int jj = 0; jj < 4; ++jj) { const int tl = 4 * q4 + jj; const bool ok = (j < i) || (r16 <= tl); SC[(16 * i + tl) * 72 + 16 * j + r16] = ok ? f2bf(sc[jj]) : (unsigned short)0; }
    }
    BARL();
    f32x16 o;
#pragma unroll
    for (int i = 0; i < 16; ++i) o[i] = 0.f;
#pragma unroll
    for (int s = 0; s < 8; ++s) { const bf16x8 a = *(const LAS bf16x8*)(QT + (32 * mt + r) * 136 + 16 * s + 8 * hh); o = MFMA32(a, sfr[s], o); }
#pragma unroll
    for (int s = 0; s < 4; ++s) { const bf16x8 a = *(const LAS bf16x8*)(SC + (32 * mt + r) * 72 + 16 * s + 8 * hh); o = MFMA32(a, vfr[s], o); }
#pragma unroll
    for (int i = 0; i < 16; ++i) { float s = o[i] * o[i];
        s += __shfl_xor(s, 1); s += __shfl_xor(s, 2); s += __shfl_xor(s, 4); s += __shfl_xor(s, 8); s += __shfl_xor(s, 16);
        if (r == 0) SSQ[(32 * mt + crow(i, hh)) * 4 + nt] = s; }
    BARL();
    const int v = 32 * nt + r;
#pragma unroll
    for (int i = 0; i < 16; ++i) { const int t = 32 * mt + crow(i, hh);
        const float ss = (SSQ[t * 4] + SSQ[t * 4 + 1]) + (SSQ[t * 4 + 2] + SSQ[t * 4 + 3]); const float rstd = rsqrtf(ss * (1.f / 128.f) + RMS_EPS);
        const size_t off2 = (row0 + t) * 512 + h * 128 + v;
        YA[off2] = f2bf(o[i] * rstd * gh * bf2f(gav[i])); }
    BARL();
}
DI void sb_wave_item(LAS unsigned char* wl, int wi, const bf16_t* QB, const bf16_t* KB, const bf16_t* VT, bf16_t* YB) {
    const int lane = threadIdx.x & 63, r = lane & 31, hh = lane >> 5;
    const int b = wi >> 11, h = (wi >> 8) & 7, qb = wi & 255, t0 = qb * 32;
    const size_t rowb = (size_t)b * T;
    bf16x8 qf[4];
    { const bf16_t* qp = QB + (rowb + t0 + r) * 512 + h * 64 + 8 * hh;
#pragma unroll
      for (int s = 0; s < 4; ++s) qf[s] = *(const bf16x8*)(qp + 16 * s); }
    f32x16 o0, o1;
#pragma unroll
    for (int i = 0; i < 16; ++i) { o0[i] = 0.f; o1[i] = 0.f; }
    float carry = 0.f;
    const bf16_t* vt0 = VT + (size_t)(512 + h * 64 + r) * M + rowb + 4 * hh; const bf16_t* vt1 = vt0 + (size_t)32 * M;
    bf16x8 kc[4]; s16x4 va0[2][2], va1[2][2];
    { const bf16_t* kp = KB + (rowb + t0 + r) * 512 + h * 64 + 8 * hh;
#pragma unroll
      for (int s = 0; s < 4; ++s) kc[s] = *(const bf16x8*)(kp + 16 * s);
#pragma unroll
      for (int s = 0; s < 2; ++s)
#pragma unroll
        for (int hf = 0; hf < 2; ++hf) { va0[s][hf] = *(const s16x4*)(vt0 + t0 + 16 * s + 8 * hf); va1[s][hf] = *(const s16x4*)(vt1 + t0 + 16 * s + 8 * hf); } }
    for (int kt = qb; kt >= 0; --kt) {
        const int keyn = (kt > 0 ? kt - 1 : 0) * 32;
        bf16x8 kn[4]; s16x4 vn0[2][2], vn1[2][2];
        { const bf16_t* kp = KB + (rowb + keyn + r) * 512 + h * 64 + 8 * hh;
#pragma unroll
          for (int s = 0; s < 4; ++s) kn[s] = *(const bf16x8*)(kp + 16 * s);
#pragma unroll
          for (int s = 0; s < 2; ++s)
#pragma unroll
            for (int hf = 0; hf < 2; ++hf) { vn0[s][hf] = *(const s16x4*)(vt0 + keyn + 16 * s + 8 * hf); vn1[s][hf] = *(const s16x4*)(vt1 + keyn + 16 * s + 8 * hf); } }
        f32x16 z;
#pragma unroll
        for (int i = 0; i < 16; ++i) z[i] = 0.f;
#pragma unroll
        for (int s = 0; s < 4; ++s) z = MFMA32(kc[s], qf[s], z);
        const bool diag = (kt == qb);
        float sp[16];
#pragma unroll
        for (int i = 0; i < 16; ++i) { const float zi = z[i]; const bool valid = !diag || (crow(i, hh) < r);
            const float spv = fmaxf(zi, 0.f) + __builtin_amdgcn_logf(1.f + __builtin_amdgcn_exp2f(-fabsf(zi))); sp[i] = valid ? spv : 0.f; }
        float Gs[4], PG[4];
#pragma unroll
        for (int g = 0; g < 4; ++g) { Gs[g] = (sp[4 * g] + sp[4 * g + 1]) + (sp[4 * g + 2] + sp[4 * g + 3]); PG[g] = __shfl_xor(Gs[g], 32); }
        float R[4]; R[3] = 0.f; R[2] = Gs[3] + PG[3]; R[1] = R[2] + (Gs[2] + PG[2]); R[0] = R[1] + (Gs[1] + PG[1]);
        const float tot = R[0] + (Gs[0] + PG[0]);
        float av[16];
#pragma unroll
        for (int g = 0; g < 4; ++g) { const float after = carry + R[g] + (hh == 0 ? PG[g] : 0.f);
            float ins = 0.f;
#pragma unroll
            for (int e = 3; e >= 0; --e) { const int i = 4 * g + e; ins += sp[i]; const bool valid = !diag || (crow(i, hh) < r);
                av[i] = valid ? __builtin_amdgcn_exp2f(z[i] - (after + ins)) : 0.f; } }
        carry += tot;
        u32x4 p0, p1;
        p0.x = cvt_pk_bf16(av[0], av[1]); p0.y = cvt_pk_bf16(av[2], av[3]); p0.z = cvt_pk_bf16(av[4], av[5]); p0.w = cvt_pk_bf16(av[6], av[7]);
        p1.x = cvt_pk_bf16(av[8], av[9]); p1.y = cvt_pk_bf16(av[10], av[11]); p1.z = cvt_pk_bf16(av[12], av[13]); p1.w = cvt_pk_bf16(av[14], av[15]);
        const bf16x8 pb0 = __builtin_bit_cast(bf16x8, p0), pb1 = __builtin_bit_cast(bf16x8, p1);
        o0 = MFMA32(__builtin_shufflevector(va0[0][0], va0[0][1], 0, 1, 2, 3, 4, 5, 6, 7), pb0, o0);
        o0 = MFMA32(__builtin_shufflevector(va0[1][0], va0[1][1], 0, 1, 2, 3, 4, 5, 6, 7), pb1, o0);
        o1 = MFMA32(__builtin_shufflevector(va1[0][0], va1[0][1], 0, 1, 2, 3, 4, 5, 6, 7), pb0, o1);
        o1 = MFMA32(__builtin_shufflevector(va1[1][0], va1[1][1], 0, 1, 2, 3, 4, 5, 6, 7), pb1, o1);
        if (__all(carry > 127.f)) break;
#pragma unroll
        for (int s = 0; s < 4; ++s) kc[s] = kn[s];
#pragma unroll
        for (int s = 0; s < 2; ++s)
#pragma unroll
            for (int hf = 0; hf < 2; ++hf) { va0[s][hf] = vn0[s][hf]; va1[s][hf] = vn1[s][hf]; }
    }
    LAS bf16_t* OL = (LAS bf16_t*)wl;
#pragma unroll
    for (int i = 0; i < 16; ++i) { OL[r * 72 + crow(i, hh)] = f2bf(o0[i]); OL[r * 72 + 32 + crow(i, hh)] = f2bf(o1[i]); }
    LDS_WAIT();
    { const int row = lane >> 1, half = lane & 1; bf16_t* gp = YB + (rowb + t0 + row) * 512 + h * 64 + half * 32;
#pragma unroll
      for (int k = 0; k < 4; ++k) *(u32x4*)(gp + 8 * k) = *(const LAS u32x4*)(OL + row * 72 + half * 32 + 8 * k); }
    LDS_WAIT();
}
DI void xattn_item(LAS unsigned char* lds, int item, const bf16_t* XQ, const bf16_t* MK, const bf16_t* MVT, bf16_t* XO) {
    const int tid = threadIdx.x, lane = tid & 63, wave = tid >> 6, r = lane & 31, hh = lane >> 5;
    const int b = item >> 7, h = (item >> 5) & 3, tile = item & 31;
    const size_t rowq = (size_t)b * T + tile * 256 + wave * 32;
    constexpr int RS = 528;
    LAS unsigned char* ring = lds;
    LAS bf16_t* OL = (LAS bf16_t*)(lds + 67584 + wave * 4608);
    const int srow = tid >> 5, sc16 = tid & 31;
    const bf16_t* kbase = MK + (size_t)(b * NMEM + srow) * 1024 + h * 256 + sc16 * 8;
    const bf16_t* vbase = MVT + (size_t)(h * 256 + srow) * 512 + b * NMEM + sc16 * 8;
    u32x4 st[4];
#define XA_LOAD(ch) do { _Pragma("unroll") for (int i_ = 0; i_ < 4; ++i_) st[i_] = ((ch) < 4) ? *(const u32x4*)(kbase + (size_t)(64 * (ch) + 16 * i_) * 1024) : *(const u32x4*)(vbase + (size_t)(64 * ((ch) - 4) + 16 * i_) * 512); } while (0)
#define XA_LOADV(ch) do { _Pragma("unroll") for (int i_ = 0; i_ < 4; ++i_) st[i_] = *(const u32x4*)(vbase + (size_t)(64 * ((ch) - 4) + 16 * i_) * 512); } while (0)
#define XA_WRITE(ch) do { _Pragma("unroll") for (int i_ = 0; i_ < 4; ++i_) *(LAS u32x4*)(ring + ((ch) & 1) * 33792 + (srow + 16 * i_) * RS + sc16 * 16) = st[i_]; } while (0)
    XA_LOAD(0);
    bf16x8 qf[16];
    { const bf16_t* qp = XQ + (rowq + r) * 1024 + h * 256 + 8 * hh;
#pragma unroll
      for (int s = 0; s < 16; ++s) qf[s] = *(const bf16x8*)(qp + 16 * s); }
    XA_WRITE(0);
    __syncthreads();
    bf16x8 P[8][2];
    float mh[4], sh[4];
#pragma unroll
    for (int ch = 0; ch < 4; ++ch) {
        f32x16 S[2];
        XA_LOAD(ch + 1);
        const LAS unsigned char* buf = ring + (ch & 1) * 33792;
#pragma unroll
        for (int m2 = 0; m2 < 2; ++m2) {
            f32x16 acc;
#pragma unroll
            for (int i = 0; i < 16; ++i) acc[i] = 0.f;
#pragma unroll
            for (int s = 0; s < 16; ++s) { acc = MFMA32(*(const LAS bf16x8*)(buf + (32 * m2 + r) * RS + (16 * s + 8 * hh) * 2), qf[s], acc); if ((s & 3) == 3) __builtin_amdgcn_sched_barrier(0); }
            S[m2] = acc;
        }
        XA_WRITE(ch + 1);
        float mx = -3.0e38f;
#pragma unroll
        for (int mt = 0; mt < 2; ++mt)
#pragma unroll
            for (int i = 0; i < 16; ++i) mx = fmaxf(mx, S[mt][i]);
        mx = fmaxf(mx, __shfl_xor(mx, 32));
        float sum = 0.f;
#pragma unroll
        for (int mt = 0; mt < 2; ++mt) {
            float p[16];
#pragma unroll
            for (int i = 0; i < 16; ++i) { p[i] = fexp(S[mt][i] - mx); sum += p[i]; }
            u32x4 p0, p1;
            p0.x = cvt_pk_bf16(p[0], p[1]); p0.y = cvt_pk_bf16(p[2], p[3]); p0.z = cvt_pk_bf16(p[4], p[5]); p0.w = cvt_pk_bf16(p[6], p[7]);
            p1.x = cvt_pk_bf16(p[8], p[9]); p1.y = cvt_pk_bf16(p[10], p[11]); p1.z = cvt_pk_bf16(p[12], p[13]); p1.w = cvt_pk_bf16(p[14], p[15]);
            P[2 * ch + mt][0] = __builtin_bit_cast(bf16x8, p0); P[2 * ch + mt][1] = __builtin_bit_cast(bf16x8, p1);
        }
        sum += __shfl_xor(sum, 32);
        mh[ch] = mx; sh[ch] = sum;
        __syncthreads();
    }
    const float mfin = fmaxf(fmaxf(mh[0], mh[1]), fmaxf(mh[2], mh[3]));
    float fq[4]; float den = 0.f;
#pragma unroll
    for (int q = 0; q < 4; ++q) { fq[q] = fexp(mh[q] - mfin); den += fq[q] * sh[q]; }
    const float inv = 1.f / den;
#pragma unroll
    for (int q = 0; q < 4; ++q) fq[q] *= inv;
#pragma unroll 1
    for (int ch = 4; ch < 8; ++ch) {
        if (ch < 7) XA_LOADV(ch + 1);
        const LAS unsigned char* buf = ring + (ch & 1) * 33792;
#pragma unroll 1
        for (int d2 = 0; d2 < 2; ++d2) {
            f32x16 O[4];
#pragma unroll
            for (int q = 0; q < 4; ++q)
#pragma unroll
                for (int i = 0; i < 16; ++i) O[q][i] = 0.f;
#pragma unroll
            for (int q = 0; q < 4; ++q)
#pragma unroll
                for (int m2 = 0; m2 < 2; ++m2)
#pragma unroll
                    for (int s = 0; s < 2; ++s) { const LAS unsigned char* vp = buf + (32 * d2 + r) * RS + (32 * (2 * q + m2) + 16 * s + 4 * hh) * 2;
                        const s16x4 lo = *(const LAS s16x4*)vp, hi = *(const LAS s16x4*)(vp + 16);
                        O[q] = MFMA32(__builtin_shufflevector(lo, hi, 0, 1, 2, 3, 4, 5, 6, 7), P[2 * q + m2][s], O[q]); if (s == 1) __builtin_amdgcn_sched_barrier(0); }
#pragma unroll
            for (int i = 0; i < 16; ++i) OL[r * 72 + 32 * d2 + crow(i, hh)] = f2bf((O[0][i] * fq[0] + O[1][i] * fq[1]) + (O[2][i] * fq[2] + O[3][i] * fq[3]));
            __builtin_amdgcn_sched_barrier(0);
        }
        LDS_WAIT();
        { const int row = lane >> 1, half = lane & 1; bf16_t* gp = XO + (rowq + row) * 1024 + h * 256 + 64 * (ch - 4) + half * 32;
#pragma unroll
          for (int k = 0; k < 4; ++k) *(u32x4*)(gp + 8 * k) = *(const LAS u32x4*)(OL + row * 72 + half * 32 + 8 * k); }
        LDS_WAIT();
        if (ch < 7) XA_WRITE(ch + 1);
        __syncthreads();
    }
#undef XA_LOAD
#undef XA_LOADV
#undef XA_WRITE
}

constexpr int NPHASE = 13;
struct Args { const float* in[19]; float* out; unsigned char* ws; int ph_lo, ph_hi, probe, pad; };
#ifndef PROBE_VAL
#define PROBE_VAL 1
#endif
#ifndef MK_ONE_LAUNCH
#define MK_ONE_LAUNCH 1
#endif

__global__ void __launch_bounds__(NTHR, 2) fwd_kernel(Args args) {
    extern __shared__ __attribute__((aligned(16))) unsigned char lds_raw[];
    LAS unsigned char* lds = (LAS unsigned char*)lds_raw;
    const int tid = threadIdx.x, lane = tid & 63, wave = __builtin_amdgcn_readfirstlane(tid >> 6);
    const int G = gridDim.x, bx = blockIdx.x;
    unsigned char* ws = args.ws; unsigned char* dob = (unsigned char*)args.out;
    const float* x = args.in[0]; const float* mem = args.in[1]; const float* g_mix = args.in[2]; const float* w_in = args.in[3]; const float* lb_table = args.in[4];
    const float* g_hgrn = args.in[5]; const float* w_gate = args.in[6]; const float* w_pa = args.in[7]; const float* w_pb = args.in[8]; const float* w_out = args.in[9];
    const float* g_xattn = args.in[10]; const float* g_mem = args.in[11]; const float* w_xq = args.in[12]; const float* w_xkv = args.in[13]; const float* w_xo = args.in[14];
    const float* g_ffn = args.in[15]; const float* w_ffn_in = args.in[16]; const float* w_ffn_out = args.in[17]; const float* g_final = args.in[18];
    float* ROWSS1 = (float*)(ws + WS_ROWSS1); float* ROWSS2 = (float*)(ws + WS_ROWSS2); float* ROWSS3 = (float*)(ws + WS_ROWSS3);
    bf16_t* MEMN = (bf16_t*)(ws + WS_MEMN); bf16_t* MK = (bf16_t*)(ws + WS_MK); bf16_t* MVT = (bf16_t*)(ws + WS_MVT);
    bf16_t* WMAIN = (bf16_t*)(ws + WS_WMAIN); bf16_t* WSWAP = (bf16_t*)(ws + WS_WSWAP); bf16_t* WA = (bf16_t*)(ws + WS_WA); bf16_t* WB = (bf16_t*)(ws + WS_WB);
    bf16_t* WOUT = (bf16_t*)(ws + WS_WOUT); bf16_t* WXQ = (bf16_t*)(ws + WS_WXQ); bf16_t* WXK = (bf16_t*)(ws + WS_WXK); bf16_t* WXV = (bf16_t*)(ws + WS_WXV);
    bf16_t* WXO = (bf16_t*)(ws + WS_WXO); bf16_t* WFI = (bf16_t*)(ws + WS_WFI); bf16_t* WFO = (bf16_t*)(ws + WS_WFO);
    bf16_t* QA = (bf16_t*)(ws + WS_QA); bf16_t* GA = (bf16_t*)(ws + WS_GA); float* LF = (float*)(ws + WS_LF); bf16_t* VT = (bf16_t*)(ws + WS_VT);
    bf16_t* GATE = (bf16_t*)(ws + WS_GATE); bf16_t* U = (bf16_t*)(ws + WS_U); bf16_t* YA = (bf16_t*)(ws + WS_YA); float* GAM = (float*)(ws + WS_GAM);
    bf16_t* T1 = (bf16_t*)(ws + WS_T1); bf16_t* MERGED = (bf16_t*)(ws + WS_MERGED); bf16_t* X1B = (bf16_t*)(ws + WS_X1B); bf16_t* XQ = (bf16_t*)(ws + WS_XQ);
    bf16_t* XO = (bf16_t*)(ws + WS_XO); bf16_t* X2B = (bf16_t*)(ws + WS_X2B); bf16_t* FFH = (bf16_t*)(ws + WS_FFH);
    bf16_t* H1 = (bf16_t*)(dob + DO_H1); bf16_t* QB = (bf16_t*)(dob + DO_QB); bf16_t* KB = (bf16_t*)(dob + DO_KB); bf16_t* YB = (bf16_t*)(dob + DO_YB);
    float* XR = args.out;

    volatile LAS unsigned* MISC = (volatile LAS unsigned*)(lds + 147392);
    if (tid < 16) MISC[tid] = 0u;
    __syncthreads();
    XcdBarrier bar; bar.bar = (unsigned*)(ws + WS_BAR); bar.x = 0; bar.st = MISC;
    if (args.ph_hi - args.ph_lo > 1) bar = xcd_barrier_post((unsigned*)(ws + WS_BAR), MISC);
    if (args.probe == 0x7fffffff) cg::this_grid().sync();
    const int lo = args.ph_lo, hi = args.ph_hi; const bool pr = args.probe != 0;
    float* PRO = (float*)(ws + 140 * MiB); bf16_t* PRB = (bf16_t*)(ws + 204 * MiB); float* PRS = (float*)(ws + 196608);
#define IN(k) (lo <= (k) && (k) < hi)
#define SEAM(k) do { if (IN(k) && IN((k) + 1)) xcd_barrier(bar); } while (0)

    if (IN(0)) {
        LAS float* scr = (LAS float*)(lds + wave * 16384);
        const int gw = bx * NWAVES + wave, NGW = G * NWAVES;
        constexpr int I_IN = 16 * 112, I_GATE = 16 * 64, I_A = 8 * 32, I_B = 8 * 32, I_OUT = 16 * 32, I_XQ = 16 * 32, I_XKV = 16 * 64, I_XO = 16 * 32, I_FI = 16 * 176, I_FO = 44 * 32;
        constexpr int NITEMS = I_IN + I_GATE + I_A + I_B + I_OUT + I_XQ + I_XKV + I_XO + I_FI + I_FO;
        for (int it = gw; it < NITEMS; it += NGW) {
            int r = it;
            if (r < I_IN) { const int nblk = 112, k0 = 64 * (r / nblk), n0 = 32 * (r % nblk), seg = n0 >> 9;
                bf16_t* dst = (seg < 2) ? WMAIN + (size_t)n0 * 1024 : (seg == 2) ? WSWAP + (size_t)(n0 - 1024) * 1024 : (seg < 6) ? WMAIN + (size_t)(n0 - 512) * 1024 : WSWAP + (size_t)(n0 - 3072 + 512) * 1024;
                p0_transpose_item(w_in, 1024, 3584, dst, nullptr, scr, k0, n0, lane); continue; } r -= I_IN;
            if (r < I_GATE) { const int nblk = 64, k0 = 64 * (r / nblk), n0 = 32 * (r % nblk); p0_transpose_item(w_gate, 1024, 2048, WMAIN + (size_t)(2560 + n0) * 1024, nullptr, scr, k0, n0, lane); continue; } r -= I_GATE;
            if (r < I_A) { const int nblk = 32, k0 = 64 * (r / nblk), n0 = 32 * (r % nblk); p0_transpose_item(w_pa, 512, 1024, WA + (size_t)n0 * 512, nullptr, scr, k0, n0, lane); continue; } r -= I_A;
            if (r < I_B) { const int nblk = 32, k0 = 64 * (r / nblk), n0 = 32 * (r % nblk); p0_transpose_item(w_pb, 512, 1024, WB + (size_t)n0 * 512, nullptr, scr, k0, n0, lane); continue; } r -= I_B;
            if (r < I_OUT) { const int nblk = 32, k0 = 64 * (r / nblk), n0 = 32 * (r % nblk); p0_transpose_item(w_out, 1024, 1024, WOUT + (size_t)n0 * 1024, nullptr, scr, k0, n0, lane); continue; } r -= I_OUT;
            if (r < I_XQ) { const int nblk = 32, k0 = 64 * (r / nblk), n0 = 32 * (r % nblk); p0_transpose_item(w_xq, 1024, 1024, WXQ + (size_t)n0 * 1024, g_xattn, scr, k0, n0, lane); continue; } r -= I_XQ;
            if (r < I_XKV) { const int nblk = 64, k0 = 64 * (r / nblk), n0 = 32 * (r % nblk);
                bf16_t* dst = n0 < 1024 ? WXK + (size_t)n0 * 1024 : WXV + (size_t)(n0 - 1024) * 1024;
                p0_transpose_item(w_xkv, 1024, 2048, dst, nullptr, scr, k0, n0, lane); continue; } r -= I_XKV;
            if (r < I_XO) { const int nblk = 32, k0 = 64 * (r / nblk), n0 = 32 * (r % nblk); p0_transpose_item(w_xo, 1024, 1024, WXO + (size_t)n0 * 1024, nullptr, scr, k0, n0, lane); continue; } r -= I_XO;
            if (r < I_FI) { const int nblk = 176, k0 = 64 * (r / nblk), n0 = 32 * (r % nblk); const int up = n0 >= DFF, j = up ? n0 - DFF : n0;
                p0_transpose_item(w_ffn_in, 1024, 2 * DFF, WFI + (size_t)(256 * (j >> 7) + 128 * up + (j & 127)) * 1024, g_ffn, scr, k0, n0, lane); continue; } r -= I_FI;
            { const int nblk = 32, k0 = 64 * (r / nblk), n0 = 32 * (r % nblk); p0_transpose_item(w_ffn_out, DFF, 1024, WFO + (size_t)n0 * DFF, nullptr, scr, k0, n0, lane); }
        }
        for (int m = gw; m < M + BATCH * NMEM; m += NGW) {
            if (m < M) rms_row_to_bf16(x + (size_t)m * D, g_mix, H1 + (size_t)m * D, lane);
            else rms_row_to_bf16(mem + (size_t)(m - M) * D, g_mem, MEMN + (size_t)(m - M) * D, lane);
        }
        __syncthreads();
    }
    SEAM(0);
    if (IN(1)) {
        { pg8::Gemm g{H1, WMAIN, M, 4608, 1024}; pg8::StaticOrder S; S.init(M, 4608, G, bx);
          pg8::EpiMain E{QA, GA, QB, KB, GATE, LF, lb_table};
          pg8::gemm_phase<pg8::EpiMain, pg8::StaticOrder, true, true>(lds, g, S, E); }
        { pg8::Gemm g{WSWAP, H1, 1024, M, 1024}; pg8::StaticOrder S; S.init(1024, M, G, bx);
          pg8::EpiStore E{VT, M};
          pg8::gemm_phase<pg8::EpiStore, pg8::StaticOrder, true, true>(lds, g, S, E); }
        { pg8::Gemm g{MEMN, WXK, BATCH * NMEM, 1024, 1024}; pg8::StaticOrder S; S.init(BATCH * NMEM, 1024, G, (bx + G - (128 % G)) % G);
          pg8::EpiStore E{MK, 1024};
          pg8::gemm_phase<pg8::EpiStore, pg8::StaticOrder, true, true>(lds, g, S, E); }
        { pg8::Gemm g{WXV, MEMN, 1024, BATCH * NMEM, 1024}; pg8::StaticOrder S; S.init(1024, BATCH * NMEM, G, (bx + G - (136 % G)) % G);
          pg8::EpiStore E{MVT, BATCH * NMEM};
          pg8::gemm_phase<pg8::EpiStore, pg8::StaticOrder, true, true>(lds, g, S, E); }
    }
    SEAM(1);
    if (IN(2)) {
        if (args.probe != 3) for (int item = bx; item < 1024; item += G) hgrn_a_item(lds, item, LF, VT, U, GAM);
        if (args.probe != 2) for (int wi = bx * NWAVES + wave; wi < 4096; wi += G * NWAVES) sb_wave_item(lds + wave * 4608, wi, QB, KB, VT, YB);
    }
    SEAM(2);
    if (IN(3)) hgrn_scan(U, pr ? (bf16_t*)(dob + 32 * MiB) : U, GAM, G);
    SEAM(3);
    if (IN(4)) { for (int item = bx; item < 1024; item += G) hgrn_e_item(lds, item, LF, QA, GA, VT, U, g_hgrn, YA); }
    SEAM(4);
    if (IN(5)) {
        { pg8::Gemm g{YA, WA, M, 1024, 512}; pg8::StaticOrder S; S.init(M, 1024, G, bx);
          pg8::EpiGate E{GATE, nullptr, T1};
          pg8::gemm_phase<pg8::EpiGate, pg8::StaticOrder, true, true>(lds, g, S, E); }
        { pg8::Gemm g{YB, WB, M, 1024, 512}; pg8::StaticOrder S; S.init(M, 1024, G, bx);
          pg8::EpiGate E{GATE + 1024, T1, MERGED};
          pg8::gemm_phase<pg8::EpiGate, pg8::StaticOrder, true, true>(lds, g, S, E); }
    }
    SEAM(5);
    if (IN(6)) { pg8::Gemm g{MERGED, WOUT, M, 1024, 1024}; pg8::StaticOrder S; S.init(M, 1024, G, bx);
        pg8::EpiResid E{x, pr ? PRO : XR, pr ? PRB : X1B, pr ? PRS : ROWSS1};
        pg8::gemm_phase<pg8::EpiResid, pg8::StaticOrder, true, true>(lds, g, S, E); }
    SEAM(6);
    if (IN(7)) { pg8::Gemm g{X1B, WXQ, M, 1024, 1024}; pg8::StaticOrder S; S.init(M, 1024, G, bx);
        pg8::EpiRowScale E{ROWSS1, XQ, 0.0625f};
        pg8::gemm_phase<pg8::EpiRowScale, pg8::StaticOrder, true, true>(lds, g, S, E); }
    SEAM(7);
    if (IN(8)) { for (int item = bx; item < 256; item += G) { xattn_item(lds, item, XQ, MK, MVT, XO); __syncthreads(); } }
    SEAM(8);
    if (IN(9)) { pg8::Gemm g{XO, WXO, M, 1024, 1024}; pg8::StaticOrder S; S.init(M, 1024, G, bx);
        pg8::EpiResid E{XR, pr ? PRO : XR, pr ? PRB : X2B, pr ? PRS : ROWSS2};
        pg8::gemm_phase<pg8::EpiResid, pg8::StaticOrder, true, true>(lds, g, S, E); }
    SEAM(9);
    if (IN(10)) { pg8::Gemm g{X2B, WFI, M, 2 * DFF, 1024}; pg8::StaticOrder S; S.init(M, 2 * DFF, G, bx);
        pg8::EpiSwiglu E{ROWSS2, FFH};
        pg8::gemm_phase<pg8::EpiSwiglu, pg8::StaticOrder, true, true>(lds, g, S, E); }
    SEAM(10);
    if (IN(11)) { pg8::Gemm g{FFH, WFO, M, 1024, DFF}; pg8::StaticOrder S; S.init(M, 1024, G, bx);
        pg8::EpiResid E{XR, pr ? (float*)(ws + 44 * MiB) : XR, nullptr, pr ? PRS : ROWSS3};
        pg8::gemm_phase<pg8::EpiResid, pg8::StaticOrder, true, true>(lds, g, S, E); }
    SEAM(11);
    if (IN(12)) {
        const int gw = bx * NWAVES + wave, NGW = G * NWAVES;
        for (int m = gw; m < M; m += NGW) {
            const float rstd = rsqrtf(ROWSS3[m] * (1.f / 1024.f) + RMS_EPS);
            f32x4* xr = (f32x4*)(XR + (size_t)m * D) + lane; const f32x4* gr = (const f32x4*)g_final + lane;
#pragma unroll
            for (int j = 0; j < 4; ++j) { f32x4 v = xr[64 * j]; const f32x4 gg = gr[64 * j]; v = v * rstd; v = v * gg; xr[64 * j] = v; }
        }
    }
#ifdef PROBE_SYNCS
    for (int i = 0; i < PROBE_SYNCS; ++i) cg::this_grid().sync();
#endif
#undef IN
#undef SEAM
}

extern "C" void kernel_launch(void* const* d_in, const int* in_sizes, int n_in, void* d_out, int out_size, void* d_ws, size_t ws_size, hipStream_t stream) {
    static int grid = 0;
    if (grid == 0) {
        if (n_in != 19 || out_size != M * D || ws_size < WS_END) { fprintf(stderr, "kernel_launch: unexpected shapes (n_in %d out %d ws %zu)\n", n_in, out_size, ws_size); grid = -1; return; }
        int dev = 0, cus = 0, per_cu = 0;
        hipGetDevice(&dev); hipDeviceGetAttribute(&cus, hipDeviceAttributeMultiprocessorCount, dev);
        hipFuncSetAttribute((const void*)fwd_kernel, hipFuncAttributeMaxDynamicSharedMemorySize, LDS_BYTES);
        hipOccupancyMaxActiveBlocksPerMultiprocessor(&per_cu, (const void*)fwd_kernel, NTHR, LDS_BYTES);
        if (per_cu < 1) { fprintf(stderr, "kernel_launch: occupancy query says %d blocks per CU\n", per_cu); per_cu = 1; }
        (void)hipGetLastError();
        grid = cus * per_cu;
        fprintf(stderr, "kernel_launch: grid %d (cus %d x %d)\n", grid, cus, per_cu);
    }
    if (grid < 0) return;
    hipMemsetAsync((char*)d_ws, 0, CTL_ZERO_BYTES, stream);
    Args a{};
    for (int i = 0; i < 19; ++i) a.in[i] = (const float*)d_in[i];
    a.out = (float*)d_out; a.ws = (unsigned char*)d_ws;
#if MK_ONE_LAUNCH
    a.ph_lo = 0; a.ph_hi = NPHASE;
    void* kargs[] = {&a};
    hipError_t e = hipLaunchCooperativeKernel((const void*)fwd_kernel, dim3(grid), dim3(NTHR), kargs, LDS_BYTES, stream);
    if (e != hipSuccess) fprintf(stderr, "cooperative launch failed: %s (grid %d)\n", hipGetErrorString(e), grid);
#else
    for (int p = 0; p < NPHASE; ++p) { a.ph_lo = p; a.ph_hi = p + 1; hipLaunchKernelGGL(fwd_kernel, dim3(grid), dim3(NTHR), LDS_BYTES, stream, a);
#ifdef PROBE_MASK
        if ((PROBE_MASK >> p) & 1) { a.probe = PROBE_VAL; for (int rr = 0; rr < PROBE_REP; ++rr) hipLaunchKernelGGL(fwd_kernel, dim3(grid), dim3(NTHR), LDS_BYTES, stream, a); a.probe = 0; }
#endif
    }
#endif
}
```
